# Optimizing an MI355X kernel written in HIP

```python
import math
import jax
import jax.numpy as jnp
from jax import lax
import numpy as np

D_MODEL = 2048
BATCH = 4
SEQ = 2048
DEPTH = 2
DEC_BATCH = 128
DEC_SEQ = 4
PAST_LEN = 16384
PAGE_SIZE = 128

MIX_WIDTH = D_MODEL
GROUP_WIDTH = MIX_WIDTH // 4
CONV_W = 4
EPS = 1e-6
PLE_DIM = 256
FFN_HIDDEN = ((8 * D_MODEL + 3 * 256 - 1) // (3 * 256)) * 256

S5_CH = GROUP_WIDTH
S5_GROUP_CH = 16
S5_GROUPS = S5_CH // S5_GROUP_CH
S5_STATE = 64

GDN_HEADS = 4
GDN_DK = GROUP_WIDTH // GDN_HEADS
GDN_DV = GROUP_WIDTH // GDN_HEADS
GDN_CHUNK = 64
GDN_CONV_DIM = 2 * GDN_HEADS * GDN_DK + GDN_HEADS * GDN_DV

SSD_INNER = GROUP_WIDTH
SSD_HEADDIM = 64
SSD_HEADS = SSD_INNER // SSD_HEADDIM
SSD_NGROUPS = 2
SSD_STATE = 128
SSD_CHUNK = 128
SSD_CONV_DIM = SSD_INNER + 2 * SSD_NGROUPS * SSD_STATE

RET_HEADS = 4
RET_DK = GROUP_WIDTH // RET_HEADS
RET_DV = GROUP_WIDTH // RET_HEADS
RET_CHUNK = 128
ROPE_BASE = 10000.0

IN_SIZES = (
    S5_CH,
    GDN_HEADS * GDN_DK, GDN_HEADS * GDN_DK, GDN_HEADS * GDN_DV, GDN_HEADS * GDN_DV, GDN_HEADS, GDN_HEADS,
    SSD_INNER, SSD_CONV_DIM, SSD_HEADS,
    RET_HEADS * RET_DK, RET_HEADS * RET_DK, RET_HEADS * RET_DV, RET_HEADS * RET_DV,
)
IN_TOTAL = sum(IN_SIZES)

kernel_name = 'hybrid_s5_gdn_ssd_retention_step'


def split_last(t, sizes):
    return jnp.split(t, [int(s) for s in np.cumsum(sizes)[:-1]], axis=-1)


def rms_norm(x, w):
    xf = x.astype(jnp.float32)
    y = xf * lax.rsqrt(jnp.mean(xf * xf, axis=-1, keepdims=True) + EPS)
    return y.astype(x.dtype) * w


def l2_normalize(x):
    xf = x.astype(jnp.float32)
    return xf * lax.rsqrt(jnp.sum(xf * xf, axis=-1, keepdims=True) + EPS)


def causal_conv(x, buf, w):
    L = x.shape[1]
    xp = jnp.concatenate([buf.astype(x.dtype), x], axis=1)
    y = xp[:, 0:L] * w[0]
    for j in range(1, CONV_W):
        y = y + xp[:, j:j + L] * w[j]
    return y, xp[:, L:]


def rotary(x, positions):
    half = x.shape[-1] // 2
    inv_freq = ROPE_BASE ** (-jnp.arange(half, dtype=jnp.float32) / half)
    ang = positions.astype(jnp.float32)[:, None] * inv_freq[None, :]
    cos = jnp.cos(ang)[None, :, None, :]
    sin = jnp.sin(ang)[None, :, None, :]
    xf = x.astype(jnp.float32)
    x1, x2 = xf[..., :half], xf[..., half:]
    return jnp.concatenate([x1 * cos - x2 * sin, x1 * sin + x2 * cos], axis=-1)


def to_chunks(t, chunk):
    L = t.shape[1]
    pad = (-L) % chunk
    t = jnp.pad(t, [(0, 0), (0, pad)] + [(0, 0)] * (t.ndim - 2))
    n = t.shape[1] // chunk
    t = t.reshape((t.shape[0], n, chunk) + t.shape[2:])
    return jnp.moveaxis(t, 2, 3)


def from_chunks(t, L):
    t = jnp.moveaxis(t, 3, 2)
    t = t.reshape((t.shape[0], t.shape[1] * t.shape[2]) + t.shape[3:])
    return t[:, :L]


def intra_decay(G):
    C = G.shape[-1]
    causal = jnp.tril(jnp.ones((C, C), dtype=bool))
    diff = G[..., :, None] - G[..., None, :]
    return jnp.where(causal, jnp.exp(jnp.where(causal, diff, 0.0)), 0.0)


def decay_linear_attention(q, k, v, log_a, s0, chunk):
    L = q.shape[1]
    C = min(chunk, L)
    qc, kc, vc = (to_chunks(t.astype(jnp.float32), C) for t in (q, k, v))
    G = jnp.cumsum(to_chunks(log_a.astype(jnp.float32), C), axis=-1)
    G_last = G[..., -1]
    scores = jnp.einsum('bnhid,bnhjd->bnhij', qc, kc) * intra_decay(G)
    intra = jnp.einsum('bnhij,bnhjv->bnhiv', scores, vc)
    chunk_states = jnp.einsum('bnhcd,bnhcv->bnhdv', kc * jnp.exp(G_last[..., None] - G)[..., None], vc)

    def step(S, inp):
        cs, gl = inp
        return S * gl[..., None, None] + cs, S

    s_final, s_prev = lax.scan(step, s0.astype(jnp.float32),
                               (jnp.moveaxis(chunk_states, 1, 0), jnp.moveaxis(jnp.exp(G_last), 1, 0)))
    s_prev = jnp.moveaxis(s_prev, 0, 1)
    inter = jnp.einsum('bnhcd,bnhdv->bnhcv', qc * jnp.exp(G)[..., None], s_prev)
    return from_chunks(intra + inter, L), s_final


def gated_delta_rule(q, k, v, beta, g, s0, chunk):
    L = q.shape[1]
    C = min(chunk, L)
    qc, kc, vc = (to_chunks(t.astype(jnp.float32), C) for t in (q, k, v))
    bc = to_chunks(beta.astype(jnp.float32), C)
    G = jnp.cumsum(to_chunks(g.astype(jnp.float32), C), axis=-1)
    decay = intra_decay(G)
    strict = jnp.tril(jnp.ones((C, C), dtype=bool), -1)
    kk = jnp.einsum('bnhid,bnhjd->bnhij', kc, kc)
    a_mat = jnp.where(strict, bc[..., :, None] * kk * decay, 0.0) + jnp.eye(C, dtype=jnp.float32)
    u = lax.linalg.triangular_solve(a_mat, vc * bc[..., None], left_side=True, lower=True, unit_diagonal=True)
    w = lax.linalg.triangular_solve(a_mat, kc * (bc * jnp.exp(G))[..., None], left_side=True, lower=True,
                                    unit_diagonal=True)
    scores = jnp.einsum('bnhid,bnhjd->bnhij', qc, kc) * decay
    q_dec = qc * jnp.exp(G)[..., None]
    k_dec = kc * jnp.exp(G[..., -1:] - G)[..., None]
    g_last = jnp.exp(G[..., -1])

    def step(S, inp):
        u_c, w_c, s_c, qd_c, kd_c, gl_c = inp
        v_new = u_c - jnp.einsum('bhcd,bhdv->bhcv', w_c, S)
        o = jnp.einsum('bhcd,bhdv->bhcv', qd_c, S) + jnp.einsum('bhij,bhjv->bhiv', s_c, v_new)
        S = S * gl_c[..., None, None] + jnp.einsum('bhcd,bhcv->bhdv', kd_c, v_new)
        return S, o

    xs = tuple(jnp.moveaxis(t, 1, 0) for t in (u, w, scores, q_dec, k_dec, g_last))
    s_final, o = lax.scan(step, s0.astype(jnp.float32), xs)
    return from_chunks(jnp.moveaxis(o, 0, 1), L), s_final


def complex_affine_combine(e1, e2):
    a1r, a1i, b1r, b1i = e1
    a2r, a2i, b2r, b2i = e2
    return (a2r * a1r - a2i * a1i, a2r * a1i + a2i * a1r,
            a2r * b1r - a2i * b1i + b2r, a2r * b1i + a2i * b1r + b2i)


def s5_mixer(u, h_re0, h_im0, lw):
    f32 = jnp.float32
    bsz, L, _ = u.shape
    a_re = lw['s5_a_re'].astype(f32)
    a_im = lw['s5_a_im'].astype(f32)
    step = jnp.exp(lw['s5_log_step'].astype(f32))[:, None]
    mag = jnp.exp(a_re * step)
    lam_re = mag * jnp.cos(a_im * step)
    lam_im = mag * jnp.sin(a_im * step)
    den = a_re * a_re + a_im * a_im
    coef_re = ((lam_re - 1.0) * a_re + lam_im * a_im) / den
    coef_im = (lam_im * a_re - (lam_re - 1.0) * a_im) / den
    b_re = lw['s5_b_re'].astype(f32)
    b_im = lw['s5_b_im'].astype(f32)
    bb_re = coef_re[..., None] * b_re - coef_im[..., None] * b_im
    bb_im = coef_re[..., None] * b_im + coef_im[..., None] * b_re
    ug = u.astype(f32).reshape(bsz, L, S5_GROUPS, S5_GROUP_CH)
    drive_re = jnp.einsum('blgc,gnc->blgn', ug, bb_re)
    drive_im = jnp.einsum('blgc,gnc->blgn', ug, bb_im)
    h0_re = h_re0.astype(f32)
    h0_im = h_im0.astype(f32)
    drive_re = drive_re.at[:, 0].add(lam_re * h0_re - lam_im * h0_im)
    drive_im = drive_im.at[:, 0].add(lam_re * h0_im + lam_im * h0_re)
    lam_re_b = jnp.broadcast_to(lam_re, drive_re.shape)
    lam_im_b = jnp.broadcast_to(lam_im, drive_im.shape)
    _, _, hs_re, hs_im = lax.associative_scan(complex_affine_combine, (lam_re_b, lam_im_b, drive_re, drive_im), axis=1)
    c_re = lw['s5_c_re'].astype(f32)
    c_im = lw['s5_c_im'].astype(f32)
    y = jnp.einsum('blgn,gcn->blgc', hs_re, c_re) - jnp.einsum('blgn,gcn->blgc', hs_im, c_im)
    y = y.reshape(bsz, L, S5_CH) + lw['s5_d'].astype(f32) * u.astype(f32)
    y = jax.nn.gelu(y)
    out = y * jax.nn.sigmoid(y @ lw['s5_w_glu'].astype(f32) + lw['s5_b_glu'].astype(f32))
    return out.astype(u.dtype), hs_re[:, -1], hs_im[:, -1]


def gdn_mixer(q, k, v, z, b_logit, a_logit, buf0, s0, lw):
    dt_out = z.dtype
    bsz, L, _ = q.shape
    qkv, buf = causal_conv(jnp.concatenate([q, k, v], axis=-1), buf0, lw['gdn_conv_w'])
    qkv = jax.nn.silu(qkv)
    qh, kh, vh = split_last(qkv, (GDN_HEADS * GDN_DK, GDN_HEADS * GDN_DK, GDN_HEADS * GDN_DV))
    qh = l2_normalize(qh.reshape(bsz, L, GDN_HEADS, GDN_DK)) * (GDN_DK ** -0.5)
    kh = l2_normalize(kh.reshape(bsz, L, GDN_HEADS, GDN_DK))
    vh = vh.reshape(bsz, L, GDN_HEADS, GDN_DV)
    beta = jax.nn.sigmoid(b_logit.astype(jnp.float32))
    g = -jnp.exp(lw['gdn_a_log'].astype(jnp.float32)) * jax.nn.softplus(
        a_logit.astype(jnp.float32) + lw['gdn_dt_bias'].astype(jnp.float32))
    o, s = gated_delta_rule(qh, kh, vh, beta, g, s0, GDN_CHUNK)
    o = o * lax.rsqrt(jnp.mean(o * o, axis=-1, keepdims=True) + EPS) * lw['gdn_norm_w'].astype(jnp.float32)
    o = o * jax.nn.silu(z.astype(jnp.float32).reshape(bsz, L, GDN_HEADS, GDN_DV))
    return o.reshape(bsz, L, GDN_HEADS * GDN_DV).astype(dt_out), buf, s


def ssd_mixer(z, xbc, dt_raw, buf0, s0, lw):
    f32 = jnp.float32
    bsz, L, _ = z.shape
    xbc, buf = causal_conv(xbc, buf0, lw['ssd_conv_w'])
    xbc = jax.nn.silu(xbc + lw['ssd_conv_b'])
    xs, bm, cm = split_last(xbc, (SSD_INNER, SSD_NGROUPS * SSD_STATE, SSD_NGROUPS * SSD_STATE))
    rep = SSD_HEADS // SSD_NGROUPS
    xs = xs.astype(f32).reshape(bsz, L, SSD_HEADS, SSD_HEADDIM)
    bm = jnp.repeat(bm.astype(f32).reshape(bsz, L, SSD_NGROUPS, SSD_STATE), rep, axis=2)
    cm = jnp.repeat(cm.astype(f32).reshape(bsz, L, SSD_NGROUPS, SSD_STATE), rep, axis=2)
    dt = jax.nn.softplus(dt_raw.astype(f32) + lw['ssd_dt_bias'].astype(f32))
    a = -jnp.exp(lw['ssd_a_log'].astype(f32))
    y, s = decay_linear_attention(cm, bm * dt[..., None], xs, dt * a, s0, SSD_CHUNK)
    y = y + xs * lw['ssd_d'].astype(f32)[:, None]
    y = y.reshape(bsz, L, SSD_INNER) * jax.nn.silu(z.astype(f32))
    y = y.reshape(bsz, L, SSD_NGROUPS, SSD_INNER // SSD_NGROUPS)
    y = y * lax.rsqrt(jnp.mean(y * y, axis=-1, keepdims=True) + EPS)
    y = y.reshape(bsz, L, SSD_INNER) * lw['ssd_norm_w'].astype(f32)
    return y.astype(z.dtype), buf, s


def retention_mixer(q, k, v, gate, s0, positions, lw):
    f32 = jnp.float32
    bsz, L, _ = q.shape
    qh = rotary(q.reshape(bsz, L, RET_HEADS, RET_DK), positions)
    kh = rotary(k.reshape(bsz, L, RET_HEADS, RET_DK), positions) * (RET_DK ** -0.5)
    vh = v.reshape(bsz, L, RET_HEADS, RET_DV)
    log_gamma = jnp.log(1.0 - 2.0 ** (-5.0 - jnp.arange(RET_HEADS, dtype=f32)))
    log_a = jnp.broadcast_to(log_gamma, (bsz, L, RET_HEADS))
    o, s = decay_linear_attention(qh, kh, vh, log_a, s0, RET_CHUNK)
    mu = jnp.mean(o, axis=-1, keepdims=True)
    var = jnp.mean((o - mu) ** 2, axis=-1, keepdims=True)
    o = ((o - mu) * lax.rsqrt(var + EPS)).reshape(bsz, L, RET_HEADS * RET_DV)
    o = o * lw['ret_ln_w'].astype(f32) + lw['ret_ln_b'].astype(f32)
    out = jax.nn.silu(gate.astype(f32)) * o
    return out.astype(q.dtype), s


def trunk_layer(h, p_emb, st, lw, positions):
    s5_re0, s5_im0, gdn_s0, gdn_buf0, ssd_s0, ssd_buf0, ret_s0 = st
    xn = rms_norm(h, lw['norm_mix'])
    (s5_u, g_q, g_k, g_v, g_z, g_b, g_a, c_z, c_xbc, c_dt, r_q, r_k, r_v, r_g) = split_last(
        xn @ lw['w_in'], IN_SIZES)
    out_a, s5_re, s5_im = s5_mixer(s5_u, s5_re0, s5_im0, lw)
    out_b, gdn_buf, gdn_s = gdn_mixer(g_q, g_k, g_v, g_z, g_b, g_a, gdn_buf0, gdn_s0, lw)
    out_c, ssd_buf, ssd_s = ssd_mixer(c_z, c_xbc, c_dt, ssd_buf0, ssd_s0, lw)
    out_d, ret_s = retention_mixer(r_q, r_k, r_v, r_g, ret_s0, positions, lw)
    mixed = jnp.concatenate([out_a, out_b, out_c, out_d], axis=-1)
    h = h + mixed @ lw['w_out']
    hn = rms_norm(h, lw['norm_ffn'])
    gate, up = split_last(hn @ lw['w_ffn_in'], (FFN_HIDDEN, FFN_HIDDEN))
    h = h + (jax.nn.silu(gate) * up) @ lw['w_ffn_out']
    ple_gate = jax.nn.sigmoid(rms_norm(h, lw['norm_ple']) @ lw['w_ple_gate'])
    h = h + ple_gate * (p_emb @ lw['w_ple_proj'])
    return h, (s5_re, s5_im, gdn_s, gdn_buf, ssd_s, ssd_buf, ret_s)


def run_trunk(x, p, states, layers, norm_final, positions):
    h = x
    per_layer = []
    for i in range(DEPTH):
        h, new_st = trunk_layer(h, p[i], [s[i] for s in states], layers[i], positions)
        per_layer.append(new_st)
    y = rms_norm(h, norm_final)
    stacked = [jnp.stack([st[j] for st in per_layer]) for j in range(len(states))]
    return y, stacked


def setup_inputs(seed: int = 0) -> dict:
    key = jax.random.key(seed)
    ks = iter(jax.random.split(key, 96))
    f32 = jnp.float32

    def nrm(shape, scale):
        return jax.random.normal(next(ks), shape, f32) * scale

    def unif(shape, lo, hi):
        return jax.random.uniform(next(ks), shape, f32, lo, hi)

    def gain(shape):
        return 1.0 + nrm(shape, 0.02)

    def dt_bias(shape):
        dt = jnp.exp(unif(shape, math.log(1e-3), math.log(1e-1)))
        return dt + jnp.log(-jnp.expm1(-dt))

    n_idx = jnp.arange(S5_STATE, dtype=f32)
    return {
        'x_prompt': nrm((BATCH, SEQ, D_MODEL), 1.0),
        'x_sample': nrm((DEC_BATCH, DEC_SEQ, D_MODEL), 1.0),
        'p_prompt': nrm((DEPTH, BATCH, SEQ, PLE_DIM), 1.0),
        'p_sample': nrm((DEPTH, DEC_BATCH, DEC_SEQ, PLE_DIM), 1.0),
        'state_s5_re': nrm((DEPTH, DEC_BATCH, S5_GROUPS, S5_STATE), 0.3),
        'state_s5_im': nrm((DEPTH, DEC_BATCH, S5_GROUPS, S5_STATE), 0.3),
        'state_gdn': nrm((DEPTH, DEC_BATCH, GDN_HEADS, GDN_DK, GDN_DV), 0.1),
        'state_gdn_conv': nrm((DEPTH, DEC_BATCH, CONV_W - 1, GDN_CONV_DIM), 1.0),
        'state_ssd': nrm((DEPTH, DEC_BATCH, SSD_HEADS, SSD_STATE, SSD_HEADDIM), 0.1),
        'state_ssd_conv': nrm((DEPTH, DEC_BATCH, CONV_W - 1, SSD_CONV_DIM), 1.0),
        'state_ret': nrm((DEPTH, DEC_BATCH, RET_HEADS, RET_DK, RET_DV), 0.3),
        'norm_mix': gain((DEPTH, D_MODEL)),
        'w_in': nrm((DEPTH, D_MODEL, IN_TOTAL), D_MODEL ** -0.5),
        's5_a_re': -0.5 + nrm((DEPTH, S5_GROUPS, S5_STATE), 0.01),
        's5_a_im': math.pi * n_idx + nrm((DEPTH, S5_GROUPS, S5_STATE), 0.01),
        's5_b_re': nrm((DEPTH, S5_GROUPS, S5_STATE, S5_GROUP_CH), (2 * S5_GROUP_CH) ** -0.5),
        's5_b_im': nrm((DEPTH, S5_GROUPS, S5_STATE, S5_GROUP_CH), (2 * S5_GROUP_CH) ** -0.5),
        's5_c_re': nrm((DEPTH, S5_GROUPS, S5_GROUP_CH, S5_STATE), S5_STATE ** -0.5),
        's5_c_im': nrm((DEPTH, S5_GROUPS, S5_GROUP_CH, S5_STATE), S5_STATE ** -0.5),
        's5_d': nrm((DEPTH, S5_CH), 0.5),
        's5_log_step': unif((DEPTH, S5_GROUPS), math.log(1e-3), math.log(1e-1)),
        's5_w_glu': nrm((DEPTH, S5_CH, S5_CH), S5_CH ** -0.5),
        's5_b_glu': nrm((DEPTH, S5_CH), 0.02),
        'gdn_conv_w': nrm((DEPTH, CONV_W, GDN_CONV_DIM), CONV_W ** -0.5),
        'gdn_a_log': jnp.log(unif((DEPTH, GDN_HEADS), 1.0, 16.0)),
        'gdn_dt_bias': dt_bias((DEPTH, GDN_HEADS)),
        'gdn_norm_w': gain((DEPTH, GDN_DV)),
        'ssd_conv_w': nrm((DEPTH, CONV_W, SSD_CONV_DIM), CONV_W ** -0.5),
        'ssd_conv_b': nrm((DEPTH, SSD_CONV_DIM), 0.02),
        'ssd_dt_bias': dt_bias((DEPTH, SSD_HEADS)),
        'ssd_a_log': jnp.log(unif((DEPTH, SSD_HEADS), 1.0, 16.0)),
        'ssd_d': gain((DEPTH, SSD_HEADS)),
        'ssd_norm_w': gain((DEPTH, SSD_INNER)),
        'ret_ln_w': gain((DEPTH, RET_HEADS * RET_DV)),
        'ret_ln_b': nrm((DEPTH, RET_HEADS * RET_DV), 0.02),
        'w_out': nrm((DEPTH, MIX_WIDTH, D_MODEL), MIX_WIDTH ** -0.5),
        'norm_ffn': gain((DEPTH, D_MODEL)),
        'w_ffn_in': nrm((DEPTH, D_MODEL, 2 * FFN_HIDDEN), D_MODEL ** -0.5),
        'w_ffn_out': nrm((DEPTH, FFN_HIDDEN, D_MODEL), FFN_HIDDEN ** -0.5),
        'norm_ple': gain((DEPTH, D_MODEL)),
        'w_ple_gate': nrm((DEPTH, D_MODEL, D_MODEL), D_MODEL ** -0.5),
        'w_ple_proj': nrm((DEPTH, PLE_DIM, D_MODEL), PLE_DIM ** -0.5),
        'norm_final': gain((D_MODEL,)),
    }


def reference(x_prompt, x_sample, p_prompt, p_sample, state_s5_re, state_s5_im, state_gdn, state_gdn_conv,
              state_ssd, state_ssd_conv, state_ret, norm_mix, w_in, s5_a_re, s5_a_im, s5_b_re, s5_b_im,
              s5_c_re, s5_c_im, s5_d, s5_log_step, s5_w_glu, s5_b_glu, gdn_conv_w, gdn_a_log, gdn_dt_bias,
              gdn_norm_w, ssd_conv_w, ssd_conv_b, ssd_dt_bias, ssd_a_log, ssd_d, ssd_norm_w, ret_ln_w, ret_ln_b,
              w_out, norm_ffn, w_ffn_in, w_ffn_out, norm_ple, w_ple_gate, w_ple_proj, norm_final):
    layers = [dict(
        norm_mix=norm_mix[i], w_in=w_in[i],
        s5_a_re=s5_a_re[i], s5_a_im=s5_a_im[i], s5_b_re=s5_b_re[i], s5_b_im=s5_b_im[i],
        s5_c_re=s5_c_re[i], s5_c_im=s5_c_im[i], s5_d=s5_d[i], s5_log_step=s5_log_step[i],
        s5_w_glu=s5_w_glu[i], s5_b_glu=s5_b_glu[i],
        gdn_conv_w=gdn_conv_w[i], gdn_a_log=gdn_a_log[i], gdn_dt_bias=gdn_dt_bias[i], gdn_norm_w=gdn_norm_w[i],
        ssd_conv_w=ssd_conv_w[i], ssd_conv_b=ssd_conv_b[i], ssd_dt_bias=ssd_dt_bias[i], ssd_a_log=ssd_a_log[i],
        ssd_d=ssd_d[i], ssd_norm_w=ssd_norm_w[i],
        ret_ln_w=ret_ln_w[i], ret_ln_b=ret_ln_b[i],
        w_out=w_out[i], norm_ffn=norm_ffn[i], w_ffn_in=w_ffn_in[i], w_ffn_out=w_ffn_out[i],
        norm_ple=norm_ple[i], w_ple_gate=w_ple_gate[i], w_ple_proj=w_ple_proj[i],
    ) for i in range(DEPTH)]

    bp = x_prompt.shape[0]

    def zeros(shape):
        return jnp.zeros((DEPTH, bp) + shape, jnp.float32)

    prompt_init = [zeros((S5_GROUPS, S5_STATE)), zeros((S5_GROUPS, S5_STATE)),
                   zeros((GDN_HEADS, GDN_DK, GDN_DV)), zeros((CONV_W - 1, GDN_CONV_DIM)),
                   zeros((SSD_HEADS, SSD_STATE, SSD_HEADDIM)), zeros((CONV_W - 1, SSD_CONV_DIM)),
                   zeros((RET_HEADS, RET_DK, RET_DV))]
    pos_prompt = jnp.arange(x_prompt.shape[1], dtype=jnp.int32)
    y_prompt, prompt_states = run_trunk(x_prompt, p_prompt, prompt_init, layers, norm_final, pos_prompt)
    (prompt_s5_re, prompt_s5_im, prompt_gdn, prompt_gdn_conv, prompt_ssd, prompt_ssd_conv,
     prompt_ret) = prompt_states

    sample_init = [state_s5_re, state_s5_im, state_gdn, state_gdn_conv, state_ssd, state_ssd_conv, state_ret]
    pos_sample = PAST_LEN + jnp.arange(x_sample.shape[1], dtype=jnp.int32)
    y_sample, sample_states = run_trunk(x_sample, p_sample, sample_init, layers, norm_final, pos_sample)
    (sample_s5_re, sample_s5_im, sample_gdn, sample_gdn_conv, sample_ssd, sample_ssd_conv,
     sample_ret) = sample_states

    return (y_prompt, y_sample,
            prompt_s5_re, prompt_s5_im, prompt_gdn, prompt_gdn_conv, prompt_ssd, prompt_ssd_conv, prompt_ret,
            sample_s5_re, sample_s5_im, sample_gdn, sample_gdn_conv, sample_ssd, sample_ssd_conv, sample_ret)
```

```cpp
#include <hip/hip_runtime.h>
#include <cstdio>
#include <cstdint>
namespace pg8 {
#define PG8_LAS __attribute__((address_space(3)))
typedef unsigned short bf16_t;
typedef short bf16x8 __attribute__((ext_vector_type(8)));
typedef float f32x4 __attribute__((ext_vector_type(4)));
typedef unsigned u32x4 __attribute__((ext_vector_type(4)));
constexpr int BM = 256, BK = 64, HALF = 128, HTB = HALF * BK * 2  , STAGE_BYTES = 8 * HTB, NXCD = 8, WGM = 8;

__host__ __device__ __forceinline__ int lds_byte(int r, int c) { const int st = (r >> 4) * 2 + (c >> 5), rr = r & 15, cc = c & 31, ob = rr * 64 + cc * 2; return st * 1024 + (ob ^ (((ob >> 9) & 1) << 5)); }
__host__ __device__ __forceinline__ void stage_rc(int b, int& R, int& C) { const int st = b / 1024, sb = b % 1024, swz = sb ^ (((sb >> 9) & 1) << 5); R = (st >> 1) * 16 + swz / 64; C = (st & 1) * 32 + (swz % 64) / 2; }
__host__ __device__ __forceinline__ int perm32(int rho) { const int n = rho >> 4, i = rho & 15; return 8 * (i >> 2) + 4 * n + (i & 3); }

struct Unit { int pm, pn, ks; };
struct Gemm { const bf16_t* A; const bf16_t* Bt; int M, N, K, ldk; };

__device__ __forceinline__ void dep_wait(const unsigned* flag, unsigned target) {
    unsigned sp = 0;
    while (__hip_atomic_load(flag, __ATOMIC_RELAXED, __HIP_MEMORY_SCOPE_AGENT) < target) { __builtin_amdgcn_s_sleep(2); if (++sp > (1u << 21)) break; }
    __builtin_amdgcn_fence(__ATOMIC_ACQUIRE, "agent");
}
struct StaticOrder {
    int nM, nN, nwg, G, c; const unsigned* dflag = nullptr; unsigned dtarget = 0; int dpm = 1 << 30;
    __host__ __device__ void init(int M, int N, int G_, int c_) { nM = M / BM; nN = N / BM; nwg = nM * nN; G = G_; c = c_; }
    __host__ __device__ bool next(int i, Unit& u) const {
        const long L = (long)i * G + c; if (L >= nwg) return false;
        int wgid = (int)L; { const int q = nwg / NXCD, r = nwg % NXCD, xcd = wgid % NXCD, off = wgid / NXCD; wgid = (xcd < r ? xcd * (q + 1) : r * (q + 1) + (xcd - r) * q) + off; }
        const int nig = WGM * nN, gid = wgid / nig, fm = gid * WGM, gsz = (nM - fm) < WGM ? (nM - fm) : WGM;
        u.pm = fm + ((wgid % nig) % gsz); u.pn = (wgid % nig) / gsz; u.ks = 0; return true;
    }
    __device__ __forceinline__ void a_ready(const Unit& u) const { if (u.pm >= dpm) dep_wait(dflag, dtarget); }
    __device__ __forceinline__ void done(const Unit&) const {}
};
struct SliceOrder {
    int pm0, nP, nN, NS, G, c; const unsigned* dflag = nullptr; unsigned dtarget = 0; int dpm = 1 << 30;
    __host__ __device__ void init(int pm0_, int nP_, int N, int NS_, int G_, int c_) { pm0 = pm0_; nP = nP_; nN = N / BM; NS = NS_; G = G_; c = c_; }
    __host__ __device__ bool next(int i, Unit& u) const {
        const long L = (long)i * G + c; if (L >= (long)nP * nN * NS) return false;
        const int per = nN * NS, l2 = (int)L; u.pm = pm0 + l2 / per; u.pn = (l2 % per) / NS; u.ks = l2 % NS; return true;
    }
    __device__ __forceinline__ void a_ready(const Unit& u) const { if (u.pm >= dpm) dep_wait(dflag, dtarget); }
    __device__ __forceinline__ void done(const Unit&) const {}
};

typedef float f32x2v __attribute__((ext_vector_type(2)));
typedef __bf16 bf16x2v __attribute__((ext_vector_type(2)));
typedef unsigned u32x2 __attribute__((ext_vector_type(2)));
typedef unsigned long long ull_t;
__device__ __forceinline__ unsigned cvt_pk_bf16(float lo, float hi) { f32x2v v = {lo, hi}; bf16x2v b = __builtin_convertvector(v, bf16x2v); return __builtin_bit_cast(unsigned, b); }
__device__ __forceinline__ float bf_lo(unsigned w) { return __uint_as_float(w << 16); }
__device__ __forceinline__ float bf_hi(unsigned w) { return __uint_as_float(w & 0xffff0000u); }
constexpr float SSQ_SCALE = 1048576.0f;
__device__ __forceinline__ float rs_from_ssq(const ull_t* ssq, int row) { return rsqrtf((float)ssq[row] * (1.0f / (SSQ_SCALE * 2048.0f)) + 1e-6f); }
__device__ __forceinline__ float sigm(float x) { return __builtin_amdgcn_rcpf(1.0f + __builtin_amdgcn_exp2f(-1.4426950408889634f * x)); }
__device__ __forceinline__ float xor32_sum(float v) { const unsigned u = __builtin_bit_cast(unsigned, v); const auto r = __builtin_amdgcn_permlane32_swap(u, u, false, false); return __builtin_bit_cast(float, (unsigned)r[0]) + __builtin_bit_cast(float, (unsigned)r[1]); }
__device__ __forceinline__ float xor16_sum(float v) { const unsigned u = __builtin_bit_cast(unsigned, v); const auto r = __builtin_amdgcn_permlane16_swap(u, u, false, false); return __builtin_bit_cast(float, (unsigned)r[0]) + __builtin_bit_cast(float, (unsigned)r[1]); }

struct EpiProj {
    static constexpr bool PERM = true, AFTER_DRAIN = false;
    bf16_t* P; float* PS; const ull_t* ssq;
    __device__ __forceinline__ void operator()(const f32x4 (&acc)[2][2][4][2], const Unit& u, int wr, int wc, int fr, int fq) const {
        const int row0 = u.pm * BM + wr * 64 + fr;
#pragma unroll
        for (int ai = 0; ai < 2; ++ai)
#pragma unroll
            for (int m = 0; m < 4; ++m) {
                const int row = row0 + ai * HALF + m * 16; const float rs = rs_from_ssq(ssq, row);
                if (u.pn < 24) {
                    bf16_t* rowp = P + (size_t)row * 6144 + u.pn * BM + wc * 32 + 8 * fq;
#pragma unroll
                    for (int bj = 0; bj < 2; ++bj) { const f32x4 v0 = acc[ai][bj][m][0] * rs, v1 = acc[ai][bj][m][1] * rs;
                        u32x4 w; w.x = cvt_pk_bf16(v0[0], v0[1]); w.y = cvt_pk_bf16(v0[2], v0[3]); w.z = cvt_pk_bf16(v1[0], v1[1]); w.w = cvt_pk_bf16(v1[2], v1[3]);
                        *(u32x4*)(rowp + bj * HALF) = w; }
                } else if (wc == 0 && fq < 2) {
                    float* pp = PS + (size_t)row * 16 + 8 * fq;
                    *(f32x4*)pp = acc[ai][0][m][0] * rs; *(f32x4*)(pp + 4) = acc[ai][0][m][1] * rs;
                }
            }
    }
};
struct EpiSwiGLU {
    static constexpr bool PERM = true, AFTER_DRAIN = false;
    bf16_t* ACT; const ull_t* ssq;
    __device__ __forceinline__ void operator()(const f32x4 (&acc)[2][2][4][2], const Unit& u, int wr, int wc, int fr, int fq) const {
        const int row0 = u.pm * BM + wr * 64 + fr;
#pragma unroll
        for (int ai = 0; ai < 2; ++ai)
#pragma unroll
            for (int m = 0; m < 4; ++m) {
                const int row = row0 + ai * HALF + m * 16; const float rs = rs_from_ssq(ssq, row);
                bf16_t* rowp = ACT + (size_t)row * 5632 + u.pn * 128 + wc * 32 + 8 * fq;
                float a[8];
#pragma unroll
                for (int n = 0; n < 2; ++n)
#pragma unroll
                    for (int j = 0; j < 4; ++j) { const float g = acc[ai][0][m][n][j] * rs, up = acc[ai][1][m][n][j] * rs; a[4 * n + j] = g * sigm(g) * up; }
                u32x4 w; w.x = cvt_pk_bf16(a[0], a[1]); w.y = cvt_pk_bf16(a[2], a[3]); w.z = cvt_pk_bf16(a[4], a[5]); w.w = cvt_pk_bf16(a[6], a[7]);
                *(u32x4*)rowp = w;
            }
    }
};
struct EpiGlu {
    static constexpr bool PERM = true, AFTER_DRAIN = false;
    const bf16_t* Y; bf16_t* MIX; const float* bglu;
    __device__ __forceinline__ void operator()(const f32x4 (&acc)[2][2][4][2], const Unit& u, int wr, int wc, int fr, int fq) const {
        const int row0 = u.pm * BM + wr * 64 + fr;
#pragma unroll
        for (int ai = 0; ai < 2; ++ai)
#pragma unroll
            for (int m = 0; m < 4; ++m) {
                const int row = row0 + ai * HALF + m * 16;
#pragma unroll
                for (int bj = 0; bj < 2; ++bj) { const int c0 = u.pn * BM + bj * HALF + wc * 32 + 8 * fq;
                    const u32x4 yw = *(const u32x4*)(Y + (size_t)row * 512 + c0); const f32x4 b0 = *(const f32x4*)(bglu + c0), b1 = *(const f32x4*)(bglu + c0 + 4);
                    const f32x4 v0 = acc[ai][bj][m][0] + b0, v1 = acc[ai][bj][m][1] + b1;
                    u32x4 w; w.x = cvt_pk_bf16(bf_lo(yw.x) * sigm(v0[0]), bf_hi(yw.x) * sigm(v0[1])); w.y = cvt_pk_bf16(bf_lo(yw.y) * sigm(v0[2]), bf_hi(yw.y) * sigm(v0[3]));
                    w.z = cvt_pk_bf16(bf_lo(yw.z) * sigm(v1[0]), bf_hi(yw.z) * sigm(v1[1])); w.w = cvt_pk_bf16(bf_lo(yw.w) * sigm(v1[2]), bf_hi(yw.w) * sigm(v1[3]));
                    *(u32x4*)(MIX + (size_t)row * 2048 + c0) = w; }
            }
    }
};
struct EpiPlain {
    static constexpr bool PERM = true, AFTER_DRAIN = false;
    bf16_t* O; int ldc;
    __device__ __forceinline__ void operator()(const f32x4 (&acc)[2][2][4][2], const Unit& u, int wr, int wc, int fr, int fq) const {
        const int row0 = u.pm * BM + wr * 64 + fr;
#pragma unroll
        for (int ai = 0; ai < 2; ++ai)
#pragma unroll
            for (int m = 0; m < 4; ++m) {
                bf16_t* rowp = O + (size_t)(row0 + ai * HALF + m * 16) * ldc + u.pn * BM + wc * 32 + 8 * fq;
#pragma unroll
                for (int bj = 0; bj < 2; ++bj) { const f32x4 v0 = acc[ai][bj][m][0], v1 = acc[ai][bj][m][1];
                    u32x4 w; w.x = cvt_pk_bf16(v0[0], v0[1]); w.y = cvt_pk_bf16(v0[2], v0[3]); w.z = cvt_pk_bf16(v1[0], v1[1]); w.w = cvt_pk_bf16(v1[2], v1[3]);
                    *(u32x4*)(rowp + bj * HALF) = w; }
            }
    }
};
typedef _Float16 f16x2 __attribute__((ext_vector_type(2)));
__device__ __forceinline__ unsigned cvt_pk_f16(float a, float b) { f16x2 h; h[0] = (_Float16)a; h[1] = (_Float16)b; return __builtin_bit_cast(unsigned, h); }
struct EpiPartial {
    static constexpr bool PERM = true, AFTER_DRAIN = false;
    unsigned short* SL;
    __device__ __forceinline__ void operator()(const f32x4 (&acc)[2][2][4][2], const Unit& u, int wr, int wc, int fr, int fq) const {
        const int col0 = u.pn * BM + wc * 32 + 8 * fq;
#pragma unroll
        for (int ai = 0; ai < 2; ++ai)
#pragma unroll
            for (int m = 0; m < 4; ++m) {
                const int row = (u.pm - 32) * BM + ai * HALF + wr * 64 + m * 16 + fr; unsigned short* rp = SL + ((size_t)u.ks * 512 + row) * 2048 + col0;
#pragma unroll
                for (int bj = 0; bj < 2; ++bj) { const f32x4 v0 = acc[ai][bj][m][0], v1 = acc[ai][bj][m][1];
                    u32x4 w; w.x = cvt_pk_f16(v0[0], v0[1]); w.y = cvt_pk_f16(v0[2], v0[3]); w.z = cvt_pk_f16(v1[0], v1[1]); w.w = cvt_pk_f16(v1[2], v1[3]);
                    *(u32x4*)(rp + bj * HALF) = w; }
            }
    }
};
struct EpiNull {
    static constexpr bool PERM = false, AFTER_DRAIN = false;
    __device__ __forceinline__ void operator()(const f32x4 (&acc)[2][2][4][2], const Unit&, int, int, int, int) const {
#pragma unroll
        for (int ai = 0; ai < 2; ++ai)
#pragma unroll
            for (int bj = 0; bj < 2; ++bj)
#pragma unroll
                for (int m = 0; m < 4; ++m)
#pragma unroll
                    for (int n = 0; n < 2; ++n) asm volatile("" :: "v"(acc[ai][bj][m][n]));
    }
};
__device__ __forceinline__ float wave_sum_dpp(float v) {
    v += __builtin_bit_cast(float, __builtin_amdgcn_update_dpp(0, __builtin_bit_cast(int, v), 0xB1, 0xF, 0xF, true));
    v += __builtin_bit_cast(float, __builtin_amdgcn_update_dpp(0, __builtin_bit_cast(int, v), 0x4E, 0xF, 0xF, true));
    v += __builtin_bit_cast(float, __builtin_amdgcn_update_dpp(0, __builtin_bit_cast(int, v), 0x141, 0xF, 0xF, true));
    v += __builtin_bit_cast(float, __builtin_amdgcn_update_dpp(0, __builtin_bit_cast(int, v), 0x140, 0xF, 0xF, true));
    const int iv = __builtin_bit_cast(int, v);
    return (__builtin_bit_cast(float, __builtin_amdgcn_readlane(iv, 0)) + __builtin_bit_cast(float, __builtin_amdgcn_readlane(iv, 16))) + (__builtin_bit_cast(float, __builtin_amdgcn_readlane(iv, 32)) + __builtin_bit_cast(float, __builtin_amdgcn_readlane(iv, 48)));
}
__device__ __forceinline__ void stage_half(const f32x4 (&acc)[2][2][4][2], int ai, PG8_LAS unsigned char* lds, int wr, int wc, int fr, int fq) {
#pragma unroll
    for (int m = 0; m < 4; ++m)
#pragma unroll
        for (int bj = 0; bj < 2; ++bj)
#pragma unroll
            for (int n = 0; n < 2; ++n) { const int rl = wr * 64 + m * 16 + fr, ck = bj * 32 + wc * 8 + n * 4 + fq; *(PG8_LAS f32x4*)(lds + rl * 1024 + ((ck ^ fr) << 4)) = acc[ai][bj][m][n]; }
}
struct EpiResidF {
    static constexpr bool PERM = false, AFTER_DRAIN = true;
    const bf16_t* baseb; bf16_t* XO; ull_t* ssq;
    __device__ __forceinline__ void operator()(const f32x4 (&)[2][2][4][2], const Unit&, int, int, int, int) const {}
    __device__ __forceinline__ void fused(f32x4 (&acc)[2][2][4][2], const Unit& u, int wr, int wc, int fr, int fq, PG8_LAS unsigned char* lds, int wid, int lane) const {
        const int col = u.pn * BM + 4 * lane;
        u32x2 bw[2][8];
#define RF_LOAD(q) do { _Pragma("unroll") for (int i = 0; i < 8; ++i) { const int rl = wid * 16 + ((q) & 1) * 8 + i; bw[(q) & 1][i] = *(const u32x2*)(baseb + (size_t)(u.pm * BM + ((q) >> 1) * HALF + rl) * 2048 + col); } } while (0)
        RF_LOAD(0);
#pragma unroll
        for (int q = 0; q < 4; ++q) {
            const int ai = q >> 1, hb = q & 1;
            if (hb == 0) { stage_half(acc, ai, lds, wr, wc, fr, fq); asm volatile("s_waitcnt lgkmcnt(0)" ::: "memory"); __builtin_amdgcn_s_barrier(); asm volatile("" ::: "memory"); }
            if (q < 3) RF_LOAD(q + 1);
            f32x4 av[8];
#pragma unroll
            for (int i = 0; i < 8; ++i) { const int rl = wid * 16 + hb * 8 + i; av[i] = *(const PG8_LAS f32x4*)(lds + rl * 1024 + ((lane ^ (rl & 15)) << 4)); }
#pragma unroll
            for (int i = 0; i < 8; ++i) { const int rl = wid * 16 + hb * 8 + i, row = u.pm * BM + ai * HALF + rl; const size_t off = (size_t)row * 2048 + col;
                const u32x2 b = bw[q & 1][i]; f32x4 o; o[0] = bf_lo(b.x) + av[i][0]; o[1] = bf_hi(b.x) + av[i][1]; o[2] = bf_lo(b.y) + av[i][2]; o[3] = bf_hi(b.y) + av[i][3];
                u32x2 w; w.x = cvt_pk_bf16(o[0], o[1]); w.y = cvt_pk_bf16(o[2], o[3]); *(u32x2*)(XO + off) = w;
                const float ss = wave_sum_dpp((o[0] * o[0] + o[1] * o[1]) + (o[2] * o[2] + o[3] * o[3]));
                if (lane == 0) atomicAdd(ssq + row, (ull_t)(ss * SSQ_SCALE + 0.5f)); }
            if (hb == 1) { asm volatile("s_waitcnt lgkmcnt(0)" ::: "memory"); __builtin_amdgcn_s_barrier(); asm volatile("" ::: "memory"); }
        }
#undef RF_LOAD
    }
};
struct EpiPleF {
    static constexpr bool PERM = false, AFTER_DRAIN = true;
    const bf16_t* XI; const bf16_t* PP; bf16_t* XO; const ull_t* ssq_in; ull_t* ssq_out;
    __device__ __forceinline__ void operator()(const f32x4 (&)[2][2][4][2], const Unit&, int, int, int, int) const {}
    __device__ __forceinline__ void fused(f32x4 (&acc)[2][2][4][2], const Unit& u, int wr, int wc, int fr, int fq, PG8_LAS unsigned char* lds, int wid, int lane) const {
        const int col = u.pn * BM + 4 * lane;
        u32x2 hw[2][8], pw[2][8];
#define PF_LOAD(q) do { _Pragma("unroll") for (int i = 0; i < 8; ++i) { const int rl = wid * 16 + ((q) & 1) * 8 + i; const size_t off = (size_t)(u.pm * BM + ((q) >> 1) * HALF + rl) * 2048 + col; \
            hw[(q) & 1][i] = *(const u32x2*)(XI + off); pw[(q) & 1][i] = *(const u32x2*)(PP + off); } } while (0)
        PF_LOAD(0);
        float rsl[2];
#pragma unroll
        for (int ai = 0; ai < 2; ++ai) rsl[ai] = rs_from_ssq(ssq_in, u.pm * BM + ai * HALF + wid * 16 + (lane & 15));
#pragma unroll
        for (int q = 0; q < 4; ++q) {
            const int ai = q >> 1, hb = q & 1;
            if (hb == 0) { stage_half(acc, ai, lds, wr, wc, fr, fq); asm volatile("s_waitcnt lgkmcnt(0)" ::: "memory"); __builtin_amdgcn_s_barrier(); asm volatile("" ::: "memory"); }
            if (q < 3) PF_LOAD(q + 1);
            f32x4 av[8];
#pragma unroll
            for (int i = 0; i < 8; ++i) { const int rl = wid * 16 + hb * 8 + i; av[i] = *(const PG8_LAS f32x4*)(lds + rl * 1024 + ((lane ^ (rl & 15)) << 4)); }
#pragma unroll
            for (int i = 0; i < 8; ++i) { const int rl = wid * 16 + hb * 8 + i, row = u.pm * BM + ai * HALF + rl; const size_t off = (size_t)row * 2048 + col;
                const float rs = __builtin_bit_cast(float, __builtin_amdgcn_readlane(__builtin_bit_cast(int, rsl[ai]), hb * 8 + i));
                const f32x4 a = av[i] * rs; const u32x2 h = hw[q & 1][i], p = pw[q & 1][i];
                f32x4 o; o[0] = bf_lo(h.x) + sigm(a[0]) * bf_lo(p.x); o[1] = bf_hi(h.x) + sigm(a[1]) * bf_hi(p.x); o[2] = bf_lo(h.y) + sigm(a[2]) * bf_lo(p.y); o[3] = bf_hi(h.y) + sigm(a[3]) * bf_hi(p.y);
                u32x2 w; w.x = cvt_pk_bf16(o[0], o[1]); w.y = cvt_pk_bf16(o[2], o[3]); *(u32x2*)(XO + off) = w;
                const float ss = wave_sum_dpp((o[0] * o[0] + o[1] * o[1]) + (o[2] * o[2] + o[3] * o[3]));
                if (lane == 0) atomicAdd(ssq_out + row, (ull_t)(ss * SSQ_SCALE + 0.5f)); }
            if (hb == 1) { asm volatile("s_waitcnt lgkmcnt(0)" ::: "memory"); __builtin_amdgcn_s_barrier(); asm volatile("" ::: "memory"); }
        }
#undef PF_LOAD
    }
};

template <class Epi, class Sched, bool ALIGN_EPI = false, bool SP2 = false>
__device__ __forceinline__ void gemm_phase(PG8_LAS unsigned char* lds, const Gemm g, const Sched& S, const Epi& E) {
    int tid_ = threadIdx.x; asm volatile("" : "+v"(tid_));
    const int tid = tid_, wid = __builtin_amdgcn_readfirstlane(tid >> 6), lane = tid & 63, wr = wid >> 2, wc = wid & 3, fr = lane & 15, fq = lane >> 4;
    int K_ = g.K; asm volatile("" : "+s"(K_));
    const int K = K_, nt = K / BK, LDK = g.ldk;
    const size_t kslice = (size_t)K * 2;
    unsigned voffA[2], voffB[2];
#pragma unroll
    for (int i = 0; i < 2; ++i) { int R, C; stage_rc(tid * 16 + i * 8192, R, C); const int Rb = Epi::PERM ? ((R & ~31) + perm32(R & 31)) : R;
        voffA[i] = (unsigned)(R * LDK + C) * 2u; voffB[i] = (unsigned)(Rb * LDK + C) * 2u; }
    const size_t kstep = (size_t)(BK * 2);
    const size_t hstep = (size_t)HALF * LDK * 2;
    const size_t tstep = 2 * hstep;
    const unsigned ldsw = (unsigned)wid * 1024u;
    const int aoff = lds_byte(wr * 64 + fr, fq * 8), boff = lds_byte(wc * 32 + fr, fq * 8);
#define PG8_SA(b, h) (((b) * 2 + (h)) * HTB)
#define PG8_SB(b, h) ((4 + (b) * 2 + (h)) * HTB)
#define PG8_STAGE(bufoff, gbase, voff) do { _Pragma("unroll") for (int _i = 0; _i < 2; ++_i) \
        __builtin_amdgcn_global_load_lds((const unsigned*)((const char*)(gbase) + (voff)[_i]), (PG8_LAS unsigned*)(lds + (bufoff) + ldsw + _i * 8192), 16, 0, 0); } while (0)
#define PG8_LDA(dst, b, h) do { _Pragma("unroll") for (int m = 0; m < 4; ++m) _Pragma("unroll") for (int k = 0; k < 2; ++k) dst[m][k] = *(const PG8_LAS bf16x8*)(lds + PG8_SA(b, h) + aoff + m * 2048 + k * 1024); } while (0)
#define PG8_LDB(dst, b, h) do { _Pragma("unroll") for (int n = 0; n < 2; ++n) _Pragma("unroll") for (int k = 0; k < 2; ++k) dst[n][k] = *(const PG8_LAS bf16x8*)(lds + PG8_SB(b, h) + boff + n * 2048 + k * 1024); } while (0)
#define PG8_MMA(ai, bj, At, Bt) do { __builtin_amdgcn_s_setprio(1); _Pragma("unroll") for (int m = 0; m < 4; ++m) _Pragma("unroll") for (int n = 0; n < 2; ++n) _Pragma("unroll") for (int k = 0; k < 2; ++k) \
        acc[ai][bj][m][n] = __builtin_amdgcn_mfma_f32_16x16x32_bf16(Bt[n][k], At[m][k], acc[ai][bj][m][n], 0, 0, 0); __builtin_amdgcn_s_setprio(0); } while (0)
#define PG8_WAIT_V(n) asm volatile("s_waitcnt vmcnt(" #n ")" ::: "memory")
#define PG8_WAIT_L(n) asm volatile("s_waitcnt lgkmcnt(" #n ")" ::: "memory")
#define PG8_BAR __builtin_amdgcn_s_barrier()
#define PG8_SCHED __builtin_amdgcn_sched_barrier(0)
    Unit cur, nxt; int ui = 0;
    if (!S.next(0, cur)) return;
    f32x4 acc[2][2][4][2];
#pragma unroll
    for (int a = 0; a < 2; ++a)
#pragma unroll
        for (int b = 0; b < 2; ++b)
#pragma unroll
            for (int m = 0; m < 4; ++m)
#pragma unroll
                for (int n = 0; n < 2; ++n) acc[a][b][m][n] = (f32x4){0.f, 0.f, 0.f, 0.f};
    bf16x8 At[4][2], B0[2][2], B1[2][2];
    const char* cA = (const char*)g.A + (size_t)cur.pm * tstep + (size_t)cur.ks * kslice; const char* cB = (const char*)g.Bt + (size_t)cur.pn * tstep + (size_t)cur.ks * kslice;
    S.a_ready(cur);
    if constexpr (SP2) {
        PG8_STAGE(PG8_SB(0, 0), cB, voffB); PG8_STAGE(PG8_SB(0, 1), cB + hstep, voffB); PG8_STAGE(PG8_SA(0, 0), cA, voffA); PG8_STAGE(PG8_SA(0, 1), cA + hstep, voffA);
        if (wr == 1) PG8_BAR;
        PG8_WAIT_V(2); PG8_BAR;
        PG8_STAGE(PG8_SB(1, 0), cB + kstep, voffB); PG8_STAGE(PG8_SA(1, 0), cA + kstep, voffA); PG8_STAGE(PG8_SB(1, 1), cB + hstep + kstep, voffB);
        PG8_WAIT_V(6); PG8_BAR;
    } else {
        PG8_STAGE(PG8_SB(0, 0), cB, voffB); PG8_STAGE(PG8_SA(0, 0), cA, voffA); PG8_STAGE(PG8_SB(0, 1), cB + hstep, voffB); PG8_STAGE(PG8_SA(0, 1), cA + hstep, voffA);
        if (wr == 1) PG8_BAR;
        PG8_WAIT_V(4); PG8_BAR;
        PG8_STAGE(PG8_SB(1, 0), cB + kstep, voffB); PG8_STAGE(PG8_SA(1, 0), cA + kstep, voffA); PG8_STAGE(PG8_SB(1, 1), cB + hstep + kstep, voffB);
        PG8_WAIT_V(6); PG8_BAR;
    }
    for (;;) {
        const bool has_next = S.next(ui + 1, nxt);
        const char* nA = has_next ? (const char*)g.A + (size_t)nxt.pm * tstep + (size_t)nxt.ks * kslice : cA; const char* nB = has_next ? (const char*)g.Bt + (size_t)nxt.pn * tstep + (size_t)nxt.ks * kslice : cB;
        for (int t = 0; t < nt; t += 2) {
            const bool last = (t == nt - 2);
            const char* a1 = cA + (size_t)(t + 1) * kstep;
            const char* a2 = last ? nA : cA + (size_t)(t + 2) * kstep; const char* b2 = last ? nB : cB + (size_t)(t + 2) * kstep;
            const char* a3 = a2 + kstep; const char* b3 = b2 + kstep;
            if (last && has_next) S.a_ready(nxt);
            if constexpr (SP2) {
            PG8_LDB(B0, 0, 0); PG8_LDB(B1, 0, 1); PG8_SCHED; PG8_LDA(At, 0, 0); PG8_STAGE(PG8_SA(1, 1), a1 + hstep, voffA);
            PG8_WAIT_V(8); PG8_WAIT_L(0); PG8_BAR; PG8_MMA(0, 0, At, B0); PG8_MMA(0, 1, At, B1); PG8_BAR; PG8_SCHED;
            PG8_LDA(At, 0, 1); PG8_STAGE(PG8_SB(0, 0), b2, voffB); PG8_STAGE(PG8_SB(0, 1), b2 + hstep, voffB); PG8_STAGE(PG8_SA(0, 0), a2, voffA);
            PG8_WAIT_V(8); PG8_WAIT_L(0); PG8_BAR; PG8_MMA(1, 0, At, B0); PG8_MMA(1, 1, At, B1); PG8_BAR; PG8_SCHED;
            PG8_LDB(B0, 1, 0); PG8_LDB(B1, 1, 1); PG8_SCHED; PG8_LDA(At, 1, 0); PG8_STAGE(PG8_SA(0, 1), a2 + hstep, voffA);
            PG8_WAIT_V(8); PG8_WAIT_L(0); PG8_BAR; PG8_MMA(0, 0, At, B0); PG8_MMA(0, 1, At, B1); PG8_BAR; PG8_SCHED;
            PG8_LDA(At, 1, 1); PG8_STAGE(PG8_SB(1, 0), b3, voffB); PG8_STAGE(PG8_SB(1, 1), b3 + hstep, voffB); PG8_STAGE(PG8_SA(1, 0), a3, voffA);
            PG8_WAIT_V(8); PG8_WAIT_L(0); PG8_BAR; PG8_MMA(1, 0, At, B0); PG8_MMA(1, 1, At, B1); PG8_BAR; PG8_SCHED;
            } else {
            PG8_LDB(B0, 0, 0); PG8_SCHED; PG8_LDA(At, 0, 0); PG8_STAGE(PG8_SA(1, 1), a1 + hstep, voffA);
            PG8_WAIT_L(8); PG8_BAR; PG8_WAIT_L(0); PG8_MMA(0, 0, At, B0); PG8_BAR; PG8_SCHED;
            PG8_LDB(B1, 0, 1); PG8_STAGE(PG8_SB(0, 0), b2, voffB);
            PG8_BAR; PG8_WAIT_L(0); PG8_MMA(0, 1, At, B1); PG8_BAR;
            PG8_LDA(At, 0, 1); PG8_STAGE(PG8_SA(0, 0), a2, voffA);
            PG8_BAR; PG8_WAIT_L(0); PG8_MMA(1, 0, At, B0); PG8_BAR; PG8_SCHED;
            PG8_STAGE(PG8_SB(0, 1), b2 + hstep, voffB);
            PG8_WAIT_V(6); PG8_BAR; PG8_MMA(1, 1, At, B1); PG8_BAR;
            PG8_LDB(B0, 1, 0); PG8_SCHED; PG8_LDA(At, 1, 0); PG8_STAGE(PG8_SA(0, 1), a2 + hstep, voffA);
            PG8_WAIT_L(8); PG8_BAR; PG8_WAIT_L(0); PG8_MMA(0, 0, At, B0); PG8_BAR; PG8_SCHED;
            PG8_LDB(B1, 1, 1); PG8_STAGE(PG8_SB(1, 0), b3, voffB);
            PG8_BAR; PG8_WAIT_L(0); PG8_MMA(0, 1, At, B1); PG8_BAR;
            PG8_LDA(At, 1, 1); PG8_STAGE(PG8_SA(1, 0), a3, voffA);
            PG8_BAR; PG8_WAIT_L(0); PG8_MMA(1, 0, At, B0); PG8_BAR; PG8_SCHED;
            PG8_STAGE(PG8_SB(1, 1), b3 + hstep, voffB);
            PG8_WAIT_V(6); PG8_BAR; PG8_MMA(1, 1, At, B1); PG8_BAR;
            }
        }
        if constexpr (ALIGN_EPI) { if (wr == 0) PG8_BAR; }
        if constexpr (!Epi::AFTER_DRAIN) { E(acc, cur, wr, wc, fr, fq); S.done(cur); }
        if (!has_next) break;
#pragma unroll
        for (int a = 0; a < 2; ++a)
#pragma unroll
            for (int b = 0; b < 2; ++b)
#pragma unroll
                for (int m = 0; m < 4; ++m)
#pragma unroll
                    for (int n = 0; n < 2; ++n) acc[a][b][m][n] = (f32x4){0.f, 0.f, 0.f, 0.f};
        cur = nxt; cA = nA; cB = nB; ++ui;
        if constexpr (ALIGN_EPI) { if (wr == 1) PG8_BAR; }
    }
    PG8_WAIT_V(0);
    if constexpr (!ALIGN_EPI) { if (wr == 0) PG8_BAR; }
    PG8_BAR;
    if constexpr (Epi::AFTER_DRAIN) { E.fused(acc, cur, wr, wc, fr, fq, lds, wid, lane); S.done(cur); }
#undef PG8_SA
#undef PG8_SB
#undef PG8_STAGE
#undef PG8_LDA
#undef PG8_LDB
#undef PG8_MMA
#undef PG8_WAIT_V
#undef PG8_WAIT_L
#undef PG8_BAR
#undef PG8_SCHED
}
}

constexpr int NWAVES = 8;
constexpr int DM = 2048, SEQ = 2048, NB = 4, MP = NB * SEQ, SB = 128, ST = 4, MS = SB * ST, M = MP + MS;
constexpr int NINP = 6400, LDP = 6144, FF = 5632, PLE = 256, NIN_SRC = 6160;
constexpr int C_S5U = 0, C_GQ = 512, C_GK = 1024, C_GV = 1536, C_GZ = 2048, C_CZ = 2560, C_XBC = 3072, C_RQ = 4096, C_RK = 4608, C_RV = 5120, C_RG = 5632;
constexpr int NCH = SEQ / 64;
constexpr float EPS = 1e-6f;
#ifndef MK_PER_PHASE
#define MK_PER_PHASE 0
#endif
constexpr int N_PHASES = 18;

enum { I_XP = 0, I_XS, I_PP, I_PS, I_S5RE, I_S5IM, I_SGDN, I_SGDNC, I_SSSD, I_SSSDC, I_SRET, I_NMIX, I_WIN, I_S5ARE, I_S5AIM, I_S5BRE, I_S5BIM, I_S5CRE, I_S5CIM, I_S5D, I_S5LS,
       I_S5WG, I_S5BG, I_GCW, I_GALOG, I_GDTB, I_GNW, I_SCW, I_SCB, I_SDTB, I_SALOG, I_SD, I_SNW, I_RLW, I_RLB, I_WOUT, I_NFFN, I_WFI, I_WFO, I_NPLE, I_WPG, I_WPP, I_NFIN, N_IN };
constexpr size_t O_YP = 0, O_YS = O_YP + (size_t)MP * DM, O_PS5RE = O_YS + (size_t)MS * DM, O_PS5IM = O_PS5RE + 2 * 4 * 32 * 64, O_PGDN = O_PS5IM + 2 * 4 * 32 * 64,
    O_PGDNC = O_PGDN + 2 * 4 * 4 * 128 * 128, O_PSSD = O_PGDNC + 2 * 4 * 3 * 1536, O_PSSDC = O_PSSD + 2 * 4 * 8 * 128 * 64, O_PRET = O_PSSDC + 2 * 4 * 3 * 1024,
    O_SS5RE = O_PRET + 2 * 4 * 4 * 128 * 128, O_SS5IM = O_SS5RE + 2 * 128 * 32 * 64, O_SGDN = O_SS5IM + 2 * 128 * 32 * 64, O_SGDNC = O_SGDN + (size_t)2 * 128 * 4 * 128 * 128,
    O_SSSD = O_SGDNC + 2 * 128 * 3 * 1536, O_SSSDC = O_SSSD + (size_t)2 * 128 * 8 * 128 * 64, O_SRET = O_SSSDC + 2 * 128 * 3 * 1024, O_END = O_SRET + (size_t)2 * 128 * 4 * 128 * 128;

constexpr size_t al256(size_t x) { return (x + 255) & ~(size_t)255; }
constexpr size_t CTL_ZERO_BYTES = 1u << 20;
constexpr int CW_DEP = 8192;
constexpr int CW_BAR = 4096;
constexpr size_t SSQ_OFF = 65536;
constexpr size_t SZ_WIN = (size_t)NINP * DM * 2, SZ_WOUT = (size_t)DM * DM * 2, SZ_WFI = (size_t)2 * FF * DM * 2, SZ_WFO = (size_t)DM * FF * 2, SZ_WPG = (size_t)DM * DM * 2,
                 SZ_WPP = (size_t)DM * PLE * 2, SZ_WGLU = (size_t)512 * 512 * 2;
constexpr size_t WO_IN = 0, WO_OUT = WO_IN + SZ_WIN, WO_FI = WO_OUT + SZ_WOUT, WO_FO = WO_FI + SZ_WFI, WO_PG = WO_FO + SZ_WFO, WO_PP = WO_PG + SZ_WPG, WO_GLU = WO_PP + SZ_WPP, WL_BYTES = WO_GLU + SZ_WGLU;
constexpr size_t WS_W = CTL_ZERO_BYTES;
constexpr size_t WS_H = WS_W + 2 * WL_BYTES;
constexpr size_t WS_XA = WS_H + (size_t)M * DM * 4;
constexpr size_t WS_XB = WS_XA + (size_t)M * DM * 2;
constexpr size_t WS_P = WS_XB + (size_t)M * DM * 2;
constexpr size_t WS_PS = WS_P + (size_t)M * LDP * 2;
constexpr size_t WS_MIX = WS_PS + (size_t)M * 16 * 4;
constexpr size_t WS_PP = WS_MIX + (size_t)M * DM * 2;
constexpr size_t WS_PEMB = WS_PP + (size_t)M * DM * 2;
constexpr size_t WS_XS = WS_PEMB + (size_t)2 * M * PLE * 2;
constexpr size_t WS_YS5 = WS_XS + (size_t)M * 512 * 2;
constexpr size_t WS_LEND = WS_YS5 + (size_t)M * 512 * 2;
constexpr size_t WS_S5T = WS_LEND + (size_t)4 * 32 * 32 * 64 * 2 * 4;
constexpr size_t S5T_LAYER = (size_t)32 * 64 * 34 * 4;
constexpr size_t WS_ROT = WS_S5T + 2 * S5T_LAYER;
constexpr size_t WS_GW = al256(WS_ROT + (size_t)2052 * 64 * 2 * 4);
constexpr size_t WS_GQ = WS_GW + (size_t)512 * 16384, WS_GSC = WS_GQ + (size_t)512 * 16384, WS_GKT = WS_GSC + (size_t)512 * 8192, WS_GU = WS_GKT + (size_t)512 * 16384, WS_GG = WS_GU + (size_t)512 * 32768;
constexpr size_t WS_RQ = WS_GG + (size_t)512 * 256;
constexpr size_t WS_RK = WS_RQ + (size_t)512 * 16384, WS_RKT = WS_RK + (size_t)512 * 16384, WS_RVT = WS_RKT + (size_t)512 * 16384, WS_RVD = WS_RVT + (size_t)512 * 16384, WS_RG = WS_RVD + (size_t)512 * 16384, WS_RDT = WS_RG + (size_t)512 * 256;
constexpr size_t WS_SQ = WS_RDT + (size_t)512 * 256;
constexpr size_t WS_SK = WS_SQ + (size_t)256 * 16384, WS_SKT = WS_SK + (size_t)256 * 16384, WS_SVT = WS_SKT + (size_t)256 * 16384, WS_SVD = WS_SVT + (size_t)1024 * 8192, WS_SG = WS_SVD + (size_t)1024 * 8192, WS_SDT = WS_SG + (size_t)1024 * 256;
constexpr size_t WS_O = WS_SDT + (size_t)1024 * 256;
constexpr size_t WS_END = WS_O + (size_t)M * 1536 * 4;
static_assert(WS_END < (size_t)719 * 1024 * 1024, "workspace budget");

constexpr int LDS_BYTES = 147456;
constexpr int MISC_OFF = LDS_BYTES - 512;
constexpr int WAVE_LDS = 17408;

#define GAS __attribute__((address_space(1)))
#define LAS __attribute__((address_space(3)))
#define DI __device__ __forceinline__
typedef unsigned short bf16;
typedef unsigned v4u __attribute__((ext_vector_type(4)));
typedef unsigned v2u __attribute__((ext_vector_type(2)));
typedef float f32x4 __attribute__((ext_vector_type(4)));
typedef float f32x2 __attribute__((ext_vector_type(2)));
typedef float f32x16 __attribute__((ext_vector_type(16)));
typedef short bf16x8 __attribute__((ext_vector_type(8)));
typedef short s16x4 __attribute__((ext_vector_type(4)));
typedef GAS unsigned gu32;
typedef unsigned long long ull;
#define RLX_AGENT __ATOMIC_RELAXED, __HIP_MEMORY_SCOPE_AGENT
#define LDS_WAIT() asm volatile("s_waitcnt lgkmcnt(0)" ::: "memory")
#define VM_WAIT() asm volatile("s_waitcnt vmcnt(0)" ::: "memory")
#define MFMA32(a, b, c) __builtin_amdgcn_mfma_f32_32x32x16_bf16((a), (b), (c), 0, 0, 0)
DI unsigned f2bf(float f) { unsigned u = __builtin_bit_cast(unsigned, f); return (u + 0x7fffu + ((u >> 16) & 1u)) >> 16; }
DI unsigned pk2(float lo, float hi) { return pg8::cvt_pk_bf16(lo, hi); }
DI float bf2f(bf16 x) { return __uint_as_float((unsigned)x << 16); }
DI float sigm(float x) { return pg8::sigm(x); }
DI float siluf(float x) { return x * sigm(x); }
DI float softplusf(float x) { return x > 20.f ? x : log1pf(__expf(x)); }
DI float geluf(float x) { const float z = 0.7978845608028654f * (x + 0.044715f * x * x * x); const float e = __builtin_amdgcn_exp2f(2.8853900817779268f * z); const float th = 1.f - 2.f * __builtin_amdgcn_rcpf(1.f + e); return 0.5f * x * (1.f + th); }
template <int CTRL> DI float dpp_f(float v) { return __builtin_bit_cast(float, __builtin_amdgcn_update_dpp(0, __builtin_bit_cast(int, v), CTRL, 0xF, 0xF, true)); }
DI float wave_sum(float v) {
    v += dpp_f<0xB1>(v);
    v += dpp_f<0x4E>(v);
    v += dpp_f<0x141>(v);
    v += dpp_f<0x140>(v);
    const int iv = __builtin_bit_cast(int, v);
    const float s0 = __builtin_bit_cast(float, __builtin_amdgcn_readlane(iv, 0)), s1 = __builtin_bit_cast(float, __builtin_amdgcn_readlane(iv, 16));
    const float s2 = __builtin_bit_cast(float, __builtin_amdgcn_readlane(iv, 32)), s3 = __builtin_bit_cast(float, __builtin_amdgcn_readlane(iv, 48));
    return (s0 + s1) + (s2 + s3);
}
DI int crow(int reg, int h) { return (reg & 3) + 8 * (reg >> 2) + 4 * h; }
template <int S> DI bf16x8 pack_step(const f32x16& x) {
    v4u p; p.x = pk2(x[8 * S], x[8 * S + 1]); p.y = pk2(x[8 * S + 2], x[8 * S + 3]); p.z = pk2(x[8 * S + 4], x[8 * S + 5]); p.w = pk2(x[8 * S + 6], x[8 * S + 7]);
    return __builtin_bit_cast(bf16x8, p);
}
DI bf16x8 ldf_nat(const bf16* p, int h) { return *(const bf16x8*)(p + 8 * h); }
DI bf16x8 ldf_perm(const bf16* p, int h) { const s16x4 lo = *(const s16x4*)(p + 4 * h), hi = *(const s16x4*)(p + 8 + 4 * h); return __builtin_shufflevector(lo, hi, 0, 1, 2, 3, 4, 5, 6, 7); }
DI unsigned vzero() { unsigned z = 0u; asm volatile("" : "+v"(z)); return z; }
DI f32x16 zero16() { f32x16 z;
#pragma unroll
    for (int i = 0; i < 16; ++i) z[i] = 0.f; return z; }

#define XB_TMO      128
#define XB_XCNT(j)  (256  + 64 * (j))
#define XB_XSUB(j)  (1280 + 64 * (j))
#define XB_XGEN(j)  (2304 + 64 * (j))
#define XB_TOP      3328
#define XB_TOPGEN   3392
#define XCD_BAR_WORDS 3456
#define XB_SPIN_CAP (1u << 18)

__device__ __forceinline__ unsigned xb_ld(unsigned* p)              { return __hip_atomic_load(p, __ATOMIC_RELAXED, __HIP_MEMORY_SCOPE_AGENT); }
__device__ __forceinline__ unsigned xb_add(unsigned* p, unsigned v) { return __hip_atomic_fetch_add(p, v, __ATOMIC_RELAXED, __HIP_MEMORY_SCOPE_AGENT); }
__device__ __forceinline__ unsigned xb_xcc_id() { return (unsigned)__builtin_amdgcn_s_getreg((3 << 11) | 20) & 0xFu; }
#define XB_SPIN(cond, bar) do { unsigned _sp = 0; while (cond) { __builtin_amdgcn_s_sleep(1); \
    if ((++_sp & 255u) == 0u) { if (xb_ld(&(bar)[XB_TMO])) break; if (_sp > XB_SPIN_CAP) { atomicAdd(&(bar)[XB_TMO], 1u); break; } } } } while (0)

struct XcdBarrier {
    unsigned* bar; unsigned x;
    volatile LAS unsigned* st;
};

__device__ __forceinline__ XcdBarrier xcd_barrier_post(unsigned* bar, volatile LAS unsigned* st) {
    XcdBarrier b; b.bar = bar; b.x = xb_xcc_id(); b.st = st;
    if (threadIdx.x == 0) (void)xb_add(&bar[XB_XCNT(b.x)], 1u);
    return b;
}
__device__ __forceinline__ void xcd_barrier_complete(unsigned* bar, unsigned x, unsigned& nloc, unsigned& nx) {
    const unsigned G = gridDim.x * gridDim.y * gridDim.z;
    unsigned sum, cnt, mine, sp = 0u;
    for (;;) {
        sum = 0u; cnt = 0u; mine = 0u;
#pragma unroll
        for (unsigned j = 0; j < 16; ++j) { const unsigned c = xb_ld(&bar[XB_XCNT(j)]); sum += c; cnt += (c > 0u) ? 1u : 0u; mine = (j == x) ? c : mine; }
        if (sum == G) break;
        __builtin_amdgcn_s_sleep(1);
        if ((++sp & 255u) == 0u) { if (xb_ld(&bar[XB_TMO])) break; if (sp > XB_SPIN_CAP) { atomicAdd(&bar[XB_TMO], 1u); break; } }
    }
    nloc = mine > 0u ? mine : 1u; nx = cnt > 0u ? cnt : 1u;
}

__device__ __forceinline__ void xcd_barrier(const XcdBarrier& b) {
    asm volatile("s_waitcnt vmcnt(0)" ::: "memory");
    __syncthreads();
    if (threadIdx.x == 0) {
        unsigned* bar = b.bar;
        __builtin_amdgcn_s_waitcnt(0);
        unsigned nloc = b.st[0], nx = b.st[1];
        if (nloc == 0u) { xcd_barrier_complete(bar, b.x, nloc, nx); b.st[0] = nloc; b.st[1] = nx; }
        const unsigned old = xb_add(&bar[XB_XSUB(b.x)], 1u);
        const unsigned gen = old / nloc;
        if (old + 1u == (gen + 1u) * nloc) {
            __builtin_amdgcn_fence(__ATOMIC_RELEASE, "agent");
            asm volatile("s_waitcnt vmcnt(0)" ::: "memory");
            const unsigned og = xb_add(&bar[XB_TOP], 1u);
            const unsigned tg = og / nx;
            if (og + 1u == (tg + 1u) * nx) xb_add(&bar[XB_TOPGEN], 1u);
            else XB_SPIN(xb_ld(&bar[XB_TOPGEN]) == tg, bar);
            __builtin_amdgcn_fence(__ATOMIC_ACQUIRE, "agent");
            xb_add(&bar[XB_XGEN(b.x)], 1u);
            asm volatile("s_waitcnt vmcnt(0)" ::: "memory");
        } else {
            XB_SPIN(xb_ld(&bar[XB_XGEN(b.x)]) == gen, bar);
            __builtin_amdgcn_fence(__ATOMIC_ACQUIRE, "agent");
            asm volatile("s_waitcnt vmcnt(0)" ::: "memory");
        }
    }
    __syncthreads();
}
#ifndef DUP_PHASE
#define DUP_PHASE -1
#endif
#ifndef EN_PREP
#define EN_PREP 31
#endif

struct Args { const float* in[N_IN]; float* out; unsigned char* ws; int ph_lo, ph_hi; };
#define CAS __attribute__((address_space(4)))
struct Ctx {
    LAS unsigned char* lds; unsigned char* ws; float* out; const CAS Args* a;
    int tid, lane, wave, vcu, G;
};
DI LAS unsigned char* lds_base() { extern __shared__ __attribute__((aligned(16))) unsigned char lds_dyn_[]; return (LAS unsigned char*)lds_dyn_; }
#define WSP(T, off) ((T*)(C.ws + (off)))
#define INP(i) (C.a->in[i])

template <int MAP> DI int col_map(int n) {
    if (MAP == 0) return n;
    if (MAP == 1) {
        if (n < 2560) return n; if (n < 4096) return n + 8; if (n < 6144) return n + 16; if (n < 6152) return 2560 + (n - 6144); if (n < 6160) return 4104 + (n - 6152); return -1;
    }
    { const int pn = n >> 8, x = n & 255; return (x >> 7) * FF + pn * 128 + (x & 127); }
}
template <int MAP, bool KS = false> DI void p0_transpose_item(const float* W, int K, int Nsrc, int Ndst, bf16* WT, LAS float* scr, int item, int lane, const float* ks = nullptr) {
    const int nblk = Ndst / 32, kb = item / nblk, nb = item % nblk, k0 = 64 * kb, n0 = 32 * nb;
    const int sc = col_map<MAP>(n0 + (lane & 31));
    float v[32];
    const float* src = W + (size_t)(k0 + (lane >> 5)) * Nsrc + (sc >= 0 ? sc : 0);
#pragma unroll
    for (int i = 0; i < 32; ++i) v[i] = __builtin_nontemporal_load(src + (size_t)(2 * i) * Nsrc);
#pragma unroll
    for (int i = 0; i < 32; ++i) scr[(2 * i + (lane >> 5)) * 33 + (lane & 31)] = sc >= 0 ? v[i] : 0.f;
    LDS_WAIT(); asm volatile("" ::: "memory");
    const int c = lane & 7;
    f32x4 k0v = {1.f, 1.f, 1.f, 1.f}, k1v = k0v; if constexpr (KS) { k0v = *(const f32x4*)(ks + k0 + 8 * c); k1v = *(const f32x4*)(ks + k0 + 8 * c + 4); }
#pragma unroll
    for (int j = 0; j < 4; ++j) { const int n = (lane >> 3) + 8 * j; const LAS float* s = scr + (8 * c) * 33 + n;
        v4u o; o.x = pk2(s[0 * 33] * k0v[0], s[1 * 33] * k0v[1]); o.y = pk2(s[2 * 33] * k0v[2], s[3 * 33] * k0v[3]); o.z = pk2(s[4 * 33] * k1v[0], s[5 * 33] * k1v[1]); o.w = pk2(s[6 * 33] * k1v[2], s[7 * 33] * k1v[3]);
        *(GAS v4u*)(WT + (size_t)(n0 + n) * K + k0 + 8 * c) = o; }
    LDS_WAIT(); asm volatile("" ::: "memory");
}
DI void p0_prologue(const Ctx& C0) {
    Ctx C = C0; C.tid = (int)threadIdx.x; C.lane = C.tid & 63; C.lds = lds_base(); asm volatile("" : "+v"(C.tid), "+v"(C.lane), "+v"(C.lds), "+s"(C.a), "+s"(C.ws), "+s"(C.out));
    LAS float* scr = (LAS float*)(C.lds + C.wave * 16384);
    const int gw = C.vcu * NWAVES + C.wave, NGW = C.G * NWAVES, lane = C.lane;
    constexpr int NI_IN = (DM / 64) * (NINP / 32), NI_OUT = (DM / 64) * (DM / 32), NI_FI = (DM / 64) * (2 * FF / 32), NI_FO = (FF / 64) * (DM / 32), NI_PG = NI_OUT, NI_PP = (PLE / 64) * (DM / 32), NI_GLU = (512 / 64) * (512 / 32);
    constexpr int PER_LAYER = NI_IN + NI_OUT + NI_FI + NI_FO + NI_PG + NI_PP + NI_GLU;
    for (int it = gw; it < 2 * PER_LAYER; it += NGW) {
        const int l = it / PER_LAYER; int r = it % PER_LAYER; unsigned char* wl = C.ws + WS_W + (size_t)l * WL_BYTES;
        if (r < NI_IN) { p0_transpose_item<1, true>(INP(I_WIN) + (size_t)l * DM * NIN_SRC, DM, NIN_SRC, NINP, (bf16*)(wl + WO_IN), scr, r, lane, INP(I_NMIX) + (size_t)l * DM); continue; } r -= NI_IN;
        if (r < NI_OUT) { p0_transpose_item<0>(INP(I_WOUT) + (size_t)l * DM * DM, DM, DM, DM, (bf16*)(wl + WO_OUT), scr, r, lane); continue; } r -= NI_OUT;
        if (r < NI_FI) { p0_transpose_item<2, true>(INP(I_WFI) + (size_t)l * DM * 2 * FF, DM, 2 * FF, 2 * FF, (bf16*)(wl + WO_FI), scr, r, lane, INP(I_NFFN) + (size_t)l * DM); continue; } r -= NI_FI;
        if (r < NI_FO) { p0_transpose_item<0>(INP(I_WFO) + (size_t)l * FF * DM, FF, DM, DM, (bf16*)(wl + WO_FO), scr, r, lane); continue; } r -= NI_FO;
        if (r < NI_PG) { p0_transpose_item<0, true>(INP(I_WPG) + (size_t)l * DM * DM, DM, DM, DM, (bf16*)(wl + WO_PG), scr, r, lane, INP(I_NPLE) + (size_t)l * DM); continue; } r -= NI_PG;
        if (r < NI_PP) { p0_transpose_item<0>(INP(I_WPP) + (size_t)l * PLE * DM, PLE, DM, DM, (bf16*)(wl + WO_PP), scr, r, lane); continue; } r -= NI_PP;
        p0_transpose_item<0>(INP(I_S5WG) + (size_t)l * 512 * 512, 512, 512, 512, (bf16*)(wl + WO_GLU), scr, r, lane);
    }
    { bf16* XB = WSP(bf16, WS_XB); ull* ssq = WSP(ull, SSQ_OFF);
      for (int m = gw; m < M; m += NGW) {
        const float* xrow = m < MP ? INP(I_XP) + (size_t)m * DM : INP(I_XS) + (size_t)(m - MP) * DM;
        float s = 0.f;
#pragma unroll
        for (int j = 0; j < 8; ++j) { const f32x4 v = *(const f32x4*)(xrow + 256 * j + 4 * lane);
            s += (v[0] * v[0] + v[1] * v[1]) + (v[2] * v[2] + v[3] * v[3]);
            v2u o; o.x = pk2(v[0], v[1]); o.y = pk2(v[2], v[3]); *(v2u*)(XB + (size_t)m * DM + 256 * j + 4 * lane) = o; }
        s = wave_sum(s);
        if (lane == 0) ssq[m] = (ull)(s * pg8::SSQ_SCALE + 0.5f);
      } }
    { bf16* PE = WSP(bf16, WS_PEMB);
      for (int m = gw; m < 2 * M; m += NGW) { const int l = m / M, r = m % M;
        const float* prow = r < MP ? INP(I_PP) + ((size_t)l * MP + r) * PLE : INP(I_PS) + ((size_t)l * MS + (r - MP)) * PLE;
        const f32x4 v = *(const f32x4*)(prow + 4 * lane); v2u o; o.x = pk2(v[0], v[1]); o.y = pk2(v[2], v[3]); *(v2u*)(PE + (size_t)m * PLE + 4 * lane) = o; } }
    for (int e = gw * 64 + lane; e < 2 * 32 * 64; e += NGW * 64) {
        const int l = e >> 11, gn = e & 2047, g = gn >> 6;
        const double are = INP(I_S5ARE)[(size_t)l * 2048 + gn], aim = INP(I_S5AIM)[(size_t)l * 2048 + gn], step = exp((double)INP(I_S5LS)[l * 32 + g]);
        const double mag = exp(are * step), ang = aim * step, lre = mag * cos(ang), lim = mag * sin(ang), den = are * are + aim * aim;
        const double cre = ((lre - 1.0) * are + lim * aim) / den, cim = (lim * are - (lre - 1.0) * aim) / den;
        float* T = WSP(float, WS_S5T + (size_t)l * S5T_LAYER);
        T[gn * 2] = (float)lre; T[gn * 2 + 1] = (float)lim;
        float* BB = T + 32 * 64 * 2 + (size_t)gn * 32; const float* bre = INP(I_S5BRE) + ((size_t)l * 2048 + gn) * 16; const float* bim = INP(I_S5BIM) + ((size_t)l * 2048 + gn) * 16;
#pragma unroll
        for (int c = 0; c < 16; ++c) { BB[c] = (float)(cre * bre[c] - cim * bim[c]); BB[16 + c] = (float)(cre * bim[c] + cim * bre[c]); }
    }
    for (int e = gw * 64 + lane; e < 2052 * 64; e += NGW * 64) {
        const int p = e >> 6, i = e & 63; const double pos = p < 2048 ? (double)p : (double)(16384 + p - 2048);
        const double inv = exp(-(double)i * (9.210340371976184 / 64.0)), ang = pos * inv;
        double rev = ang * 0.15915494309189535; rev -= floor(rev); const float a = (float)(rev * 6.283185307179586);
        float* R = WSP(float, WS_ROT) + (size_t)e * 2; R[0] = cosf(a); R[1] = sinf(a);
    }
}

template <int W, bool CONV> DI void load_tile(const Ctx& C, LAS float* T, int ldt, int row0, bool has_prev, int col0, const float* cw, const float* cb, int ch0, int CW) {
    const bf16* P = WSP(bf16, WS_P);
    constexpr int NG = 512 / W, TPG = 64 / NG;
    const int ch = C.tid % W, t0 = (C.tid / W) * TPG;
    const bf16* src = P + (size_t)row0 * LDP + col0 + ch;
    bf16 raw[TPG + 3];
    const bool prev = CONV && (t0 > 0 || has_prev);
#pragma unroll
    for (int t = 0; t < TPG + 3; ++t) raw[t] = (t >= 3 || prev) ? src[(long)(t0 + t - 3) * LDP] : (bf16)0;
    if (CONV) {
        const float w0 = cw[ch0 + ch], w1 = cw[CW + ch0 + ch], w2 = cw[2 * CW + ch0 + ch], w3 = cw[3 * CW + ch0 + ch], bb = cb ? cb[ch0 + ch] : 0.f;
#pragma unroll
        for (int t = 0; t < TPG; ++t) { const float y = w0 * bf2f(raw[t]) + w1 * bf2f(raw[t + 1]) + w2 * bf2f(raw[t + 2]) + w3 * bf2f(raw[t + 3]) + bb; T[(t0 + t) * ldt + ch] = siluf(y); }
    } else {
#pragma unroll
        for (int t = 0; t < TPG; ++t) T[(t0 + t) * ldt + ch] = bf2f(raw[t + 3]);
    }
}
template <int W> DI void write_T(const Ctx& C, bf16* dst  , const LAS float* T, int ldt, const LAS float* rowscale) {
    for (int e = C.tid; e < W * 8; e += 512) { const int d = e % W, c0 = (e / W) * 8;
        float v[8];
#pragma unroll
        for (int i = 0; i < 8; ++i) v[i] = T[(c0 + i) * ldt + d] * (rowscale ? rowscale[c0 + i] : 1.f);
        v4u o; o.x = pk2(v[0], v[1]); o.y = pk2(v[2], v[3]); o.z = pk2(v[4], v[5]); o.w = pk2(v[6], v[7]);
        *(v4u*)(dst + d * 64 + c0) = o; }
}
template <int W> DI void write_R(const Ctx& C, bf16* dst  , const LAS float* T, int ldt) {
    for (int e = C.tid; e < 64 * W / 8; e += 512) { const int t = e / (W / 8), d0 = (e % (W / 8)) * 8; const LAS float* sp = T + t * ldt + d0;
        v4u o; o.x = pk2(sp[0], sp[1]); o.y = pk2(sp[2], sp[3]); o.z = pk2(sp[4], sp[5]); o.w = pk2(sp[6], sp[7]);
        *(v4u*)(dst + t * W + d0) = o; }
}
DI void conv_state_out(const Ctx& C, float* out  , int CW, int b, int col0, int chbase, int nch) {
    const bf16* P = WSP(bf16, WS_P);
    for (int e = C.tid; e < 3 * nch; e += 512) { const int j = e / nch, ch = e % nch; out[j * CW + chbase + ch] = bf2f(P[(size_t)(b * SEQ + SEQ - 3 + j) * LDP + col0 + ch]); }
}

DI void gdn_prep_item(const Ctx& C0, int l, int item) {
    Ctx C = C0; C.tid = (int)threadIdx.x; C.lane = C.tid & 63; C.lds = lds_base(); asm volatile("" : "+v"(C.tid), "+v"(C.lane), "+v"(C.lds), "+s"(C.a), "+s"(C.ws), "+s"(C.out));
    const int c = item & 31, bh = item >> 5, hh = bh & 3, b = bh >> 2, row0 = b * SEQ + 64 * c, tid = C.tid, lane = C.lane;
    LAS float* TQ = (LAS float*)(C.lds); LAS float* TK = (LAS float*)(C.lds + 33024); LAS float* TV = (LAS float*)(C.lds + 66048);
    LAS bf16* QB = (LAS bf16*)(C.lds + 99072); LAS bf16* KB = (LAS bf16*)(C.lds + 116480);
    LAS float* SBETA = (LAS float*)(C.lds + 133888); LAS float* SG = (LAS float*)(C.lds + 134144); LAS float* AT = TQ;
    const float* cw = INP(I_GCW) + (size_t)l * 4 * 1536;
    load_tile<128, true>(C, TQ, 129, row0, c > 0, C_GQ + hh * 128, cw, nullptr, hh * 128, 1536);
    load_tile<128, true>(C, TK, 129, row0, c > 0, C_GK + hh * 128, cw, nullptr, 512 + hh * 128, 1536);
    load_tile<128, true>(C, TV, 129, row0, c > 0, C_GV + hh * 128, cw, nullptr, 1024 + hh * 128, 1536);
    if (C.wave == 0) {
        const float* ps = WSP(float, WS_PS) + (size_t)(row0 + lane) * 16;
        const float beta = sigm(ps[hh]); const float g = -__expf(INP(I_GALOG)[l * 4 + hh]) * softplusf(ps[4 + hh] + INP(I_GDTB)[l * 4 + hh]);
        float Gc = g;
#pragma unroll
        for (int o = 1; o < 64; o <<= 1) { const float v = __shfl_up(Gc, o); if (lane >= o) Gc += v; }
        SBETA[lane] = beta; SG[lane] = Gc;
    }
    __syncthreads();
    for (int rr = 0; rr < 16; ++rr) {
        const int row = C.wave * 16 + rr;
        if (row < 64) { LAS float* T = TQ + row * 129; const float x0 = T[lane], x1 = T[lane + 64]; const float sc = rsqrtf(wave_sum(x0 * x0 + x1 * x1) + EPS) * 0.08838834764831845f;
            QB[row * 136 + lane] = (bf16)f2bf(x0 * sc); QB[row * 136 + lane + 64] = (bf16)f2bf(x1 * sc); }
        else { LAS float* T = TK + (row - 64) * 129; float x0 = T[lane], x1 = T[lane + 64]; const float sc = rsqrtf(wave_sum(x0 * x0 + x1 * x1) + EPS); x0 *= sc; x1 *= sc;
            T[lane] = x0; T[lane + 64] = x1; KB[(row - 64) * 136 + lane] = (bf16)f2bf(x0); KB[(row - 64) * 136 + lane + 64] = (bf16)f2bf(x1); }
    }
    __syncthreads();
    {
        const int w = C.wave, isq = w >> 2, ti = (w >> 1) & 1, tj = w & 1, r = lane & 31, h = lane >> 5;
        if (tj <= ti) {
            f32x16 acc = zero16();
            const LAS bf16* X = isq ? QB : KB;
#pragma unroll
            for (int s = 0; s < 8; ++s) { const bf16x8 a = *(const LAS bf16x8*)(X + (32 * ti + r) * 136 + 16 * s + 8 * h); const bf16x8 bb = *(const LAS bf16x8*)(KB + (32 * tj + r) * 136 + 16 * s + 8 * h); acc = MFMA32(a, bb, acc); }
            const int j = 32 * tj + r; const float Gj = SG[j];
            bf16* SC = WSP(bf16, WS_GSC) + (size_t)item * 4096;
#pragma unroll
            for (int reg = 0; reg < 16; ++reg) { const int i = 32 * ti + crow(reg, h); const float dec = __expf(SG[i] - Gj);
                if (!isq) AT[j * 68 + i] = (i > j) ? SBETA[i] * acc[reg] * dec : 0.f;
                else SC[i * 64 + j] = (bf16)f2bf((i >= j) ? acc[reg] * dec : 0.f); }
        }
    }
    __syncthreads();
    if (tid < 256) {
        const int col = tid & 127; const bool isW = tid >= 128;
        float x[64];
#pragma unroll
        for (int i = 0; i < 64; ++i) x[i] = isW ? TK[i * 129 + col] * SBETA[i] * __expf(SG[i]) : TV[i * 129 + col] * SBETA[i];
        f32x4 acol[2][16];
#pragma unroll
        for (int q = 0; q < 16; ++q) acol[0][q] = *(const LAS f32x4*)(AT + 4 * q);
#pragma unroll
        for (int j = 0; j < 63; ++j) {
            if (j + 1 < 63) {
#pragma unroll
                for (int q = (j + 2) / 4; q < 16; ++q) acol[(j + 1) & 1][q] = *(const LAS f32x4*)(AT + (j + 1) * 68 + 4 * q);
            }
#pragma unroll
            for (int q = (j + 1) / 4; q < 16; ++q) { const f32x4 a = acol[j & 1][q];
#pragma unroll
                for (int e = 0; e < 4; ++e) if (4 * q + e > j) x[4 * q + e] -= a[e] * x[j]; }
        }
        if (isW) { bf16* Wp = WSP(bf16, WS_GW) + (size_t)item * 8192;
#pragma unroll
            for (int i = 0; i < 64; ++i) Wp[i * 128 + col] = (bf16)f2bf(x[i]); }
        else { float* Up = WSP(float, WS_GU) + (size_t)item * 8192;
#pragma unroll
            for (int i = 0; i < 64; ++i) Up[i * 128 + col] = x[i]; }
    } else {
        const int t2 = tid - 256;
        { bf16* Qp = WSP(bf16, WS_GQ) + (size_t)item * 8192; const int row = t2 >> 2, seg = t2 & 3;
#pragma unroll
          for (int q = 0; q < 4; ++q) *(v4u*)(Qp + row * 128 + seg * 32 + 8 * q) = *(const LAS v4u*)(QB + row * 136 + seg * 32 + 8 * q); }
        { bf16* KT = WSP(bf16, WS_GKT) + (size_t)item * 8192; const int cc = t2 & 63, d0 = (t2 >> 6) * 32; const float sc = __expf(SG[63] - SG[cc]);
          for (int d = d0; d < d0 + 32; ++d) KT[d * 64 + cc] = (bf16)f2bf(TK[cc * 129 + d] * sc); }
        if (t2 < 64) WSP(float, WS_GG)[(size_t)item * 64 + t2] = SG[t2];
    }
    if (c == NCH - 1) { float* o = C.out + O_PGDNC + (size_t)(l * 4 + b) * 3 * 1536;
        conv_state_out(C, o, 1536, b, C_GQ + hh * 128, hh * 128, 128); conv_state_out(C, o, 1536, b, C_GK + hh * 128, 512 + hh * 128, 128); conv_state_out(C, o, 1536, b, C_GV + hh * 128, 1024 + hh * 128, 128); }
    __syncthreads();
}

DI void ret_prep_item(const Ctx& C0, int l, int item) {
    Ctx C = C0; C.tid = (int)threadIdx.x; C.lane = C.tid & 63; C.lds = lds_base(); asm volatile("" : "+v"(C.tid), "+v"(C.lane), "+v"(C.lds), "+s"(C.a), "+s"(C.ws), "+s"(C.out));
    const int c = item & 31, bh = item >> 5, hh = bh & 3, b = bh >> 2, row0 = b * SEQ + 64 * c, tid = C.tid;
    LAS float* TQ = (LAS float*)(C.lds); LAS float* TK = (LAS float*)(C.lds + 33024); LAS float* TV = (LAS float*)(C.lds + 66048); LAS float* SDEC = (LAS float*)(C.lds + 99072);
    load_tile<128, false>(C, TQ, 129, row0, false, C_RQ + hh * 128, nullptr, nullptr, 0, 0);
    load_tile<128, false>(C, TK, 129, row0, false, C_RK + hh * 128, nullptr, nullptr, 0, 0);
    load_tile<128, false>(C, TV, 129, row0, false, C_RV + hh * 128, nullptr, nullptr, 0, 0);
    const float lg = hh == 0 ? -3.1748698315e-02f : hh == 1 ? -1.5748356968e-02f : hh == 2 ? -7.8431774610e-03f : -3.9138993211e-03f;
    if (tid < 64) { SDEC[tid] = __expf((float)(63 - tid) * lg); WSP(float, WS_RG)[(size_t)item * 64 + tid] = (float)(tid + 1) * lg; WSP(float, WS_RDT)[(size_t)item * 64 + tid] = 1.f; }
    __syncthreads();
    { const float* ROT = WSP(float, WS_ROT);
      f32x2 csv[8];
#pragma unroll
      for (int k = 0; k < 8; ++k) { const int p = tid + 512 * k, t = p >> 6, i = p & 63; csv[k] = *(const f32x2*)(ROT + ((size_t)(64 * c + t) * 64 + i) * 2); }
#pragma unroll
      for (int k = 0; k < 8; ++k) { const int p = tid + 512 * k, t = p >> 6, i = p & 63; const f32x2 cs = csv[k];
        const float q1 = TQ[t * 129 + i], q2 = TQ[t * 129 + i + 64], k1 = TK[t * 129 + i], k2 = TK[t * 129 + i + 64];
        TQ[t * 129 + i] = q1 * cs.x - q2 * cs.y; TQ[t * 129 + i + 64] = q1 * cs.y + q2 * cs.x;
        TK[t * 129 + i] = (k1 * cs.x - k2 * cs.y) * 0.08838834764831845f; TK[t * 129 + i + 64] = (k1 * cs.y + k2 * cs.x) * 0.08838834764831845f; } }
    __syncthreads();
    write_R<128>(C, WSP(bf16, WS_RQ) + (size_t)item * 8192, TQ, 129);
    write_R<128>(C, WSP(bf16, WS_RK) + (size_t)item * 8192, TK, 129);
    write_T<128>(C, WSP(bf16, WS_RKT) + (size_t)item * 8192, TK, 129, nullptr);
    write_T<128>(C, WSP(bf16, WS_RVT) + (size_t)item * 8192, TV, 129, nullptr);
    write_T<128>(C, WSP(bf16, WS_RVD) + (size_t)item * 8192, TV, 129, SDEC);
    __syncthreads();
}

DI void ssdg_prep_item(const Ctx& C0, int l, int item) {
    Ctx C = C0; C.tid = (int)threadIdx.x; C.lane = C.tid & 63; C.lds = lds_base(); asm volatile("" : "+v"(C.tid), "+v"(C.lane), "+v"(C.lds), "+s"(C.a), "+s"(C.ws), "+s"(C.out));
    const int c = item & 31, bg = item >> 5, grp = bg & 1, b = bg >> 1, row0 = b * SEQ + 64 * c;
    LAS float* TB = (LAS float*)(C.lds); LAS float* TC = (LAS float*)(C.lds + 33024);
    const float* cw = INP(I_SCW) + (size_t)l * 4 * 1024; const float* cb = INP(I_SCB) + (size_t)l * 1024;
    load_tile<128, true>(C, TB, 129, row0, c > 0, C_XBC + 512 + grp * 128, cw, cb, 512 + grp * 128, 1024);
    load_tile<128, true>(C, TC, 129, row0, c > 0, C_XBC + 768 + grp * 128, cw, cb, 768 + grp * 128, 1024);
    __syncthreads();
    write_R<128>(C, WSP(bf16, WS_SQ) + (size_t)item * 8192, TC, 129);
    write_R<128>(C, WSP(bf16, WS_SK) + (size_t)item * 8192, TB, 129);
    write_T<128>(C, WSP(bf16, WS_SKT) + (size_t)item * 8192, TB, 129, nullptr);
    if (c == NCH - 1) { float* o = C.out + O_PSSDC + (size_t)(l * 4 + b) * 3 * 1024;
        conv_state_out(C, o, 1024, b, C_XBC + 512 + grp * 128, 512 + grp * 128, 128); conv_state_out(C, o, 1024, b, C_XBC + 768 + grp * 128, 768 + grp * 128, 128); }
    __syncthreads();
}

DI void ssdh_prep_item(const Ctx& C0, int l, int item) {
    Ctx C = C0; C.tid = (int)threadIdx.x; C.lane = C.tid & 63; C.lds = lds_base(); asm volatile("" : "+v"(C.tid), "+v"(C.lane), "+v"(C.lds), "+s"(C.a), "+s"(C.ws), "+s"(C.out));
    const int c = item & 31, bh = item >> 5, hh = bh & 7, b = bh >> 3, row0 = b * SEQ + 64 * c, tid = C.tid, lane = C.lane;
    LAS float* TX = (LAS float*)(C.lds); LAS float* SSC = (LAS float*)(C.lds + 16640);
    const float* cw = INP(I_SCW) + (size_t)l * 4 * 1024; const float* cb = INP(I_SCB) + (size_t)l * 1024;
    load_tile<64, true>(C, TX, 65, row0, c > 0, C_XBC + hh * 64, cw, cb, hh * 64, 1024);
    if (C.wave == 0) {
        const float dt = softplusf(WSP(float, WS_PS)[(size_t)(row0 + lane) * 16 + 8 + hh] + INP(I_SDTB)[l * 8 + hh]); const float g = -__expf(INP(I_SALOG)[l * 8 + hh]) * dt;
        float Gc = g;
#pragma unroll
        for (int o = 1; o < 64; o <<= 1) { const float v = __shfl_up(Gc, o); if (lane >= o) Gc += v; }
        const float Glast = __builtin_bit_cast(float, __builtin_amdgcn_readlane(__builtin_bit_cast(int, Gc), 63));
        SSC[lane] = dt * __expf(Glast - Gc); WSP(float, WS_SG)[(size_t)item * 64 + lane] = Gc; WSP(float, WS_SDT)[(size_t)item * 64 + lane] = dt;
    }
    __syncthreads();
    write_T<64>(C, WSP(bf16, WS_SVT) + (size_t)item * 4096, TX, 65, nullptr);
    write_T<64>(C, WSP(bf16, WS_SVD) + (size_t)item * 4096, TX, 65, SSC);
    { bf16* XS = WSP(bf16, WS_XS); for (int e = tid; e < 64 * 64; e += 512) { const int t = e >> 6, p = e & 63; XS[(size_t)(row0 + t) * 512 + hh * 64 + p] = (bf16)f2bf(TX[t * 65 + p]); } }
    if (c == NCH - 1) conv_state_out(C, C.out + O_PSSDC + (size_t)(l * 4 + b) * 3 * 1024, 1024, b, C_XBC + hh * 64, hh * 64, 64);
    __syncthreads();
}

DI void s5_load_consts(const Ctx& C, int l, int g, float& lre, float& lim, float (&bb)[32]) {
    const float* T = WSP(float, WS_S5T + (size_t)l * S5T_LAYER); const int gn = g * 64 + C.lane;
    lre = T[gn * 2]; lim = T[gn * 2 + 1];
    const f32x4* B4 = (const f32x4*)(T + 32 * 64 * 2 + (size_t)gn * 32);
#pragma unroll
    for (int q = 0; q < 8; ++q) { const f32x4 v = B4[q]; bb[4 * q] = v[0]; bb[4 * q + 1] = v[1]; bb[4 * q + 2] = v[2]; bb[4 * q + 3] = v[3]; }
}
DI void s5_stage_load(const bf16* P0, int nrows, int lane, v4u& u0, v4u& u1) {
    if (lane < nrows) { u0 = *(const v4u*)(P0 + (size_t)lane * LDP); u1 = *(const v4u*)(P0 + (size_t)lane * LDP + 8); }
}
DI void s5_stage_store(LAS float* US, int nrows, int lane, const v4u& u0, const v4u& u1) {
    if (lane < nrows) {
        f32x4 a, b, c, d;
        a[0] = pg8::bf_lo(u0.x); a[1] = pg8::bf_hi(u0.x); a[2] = pg8::bf_lo(u0.y); a[3] = pg8::bf_hi(u0.y); b[0] = pg8::bf_lo(u0.z); b[1] = pg8::bf_hi(u0.z); b[2] = pg8::bf_lo(u0.w); b[3] = pg8::bf_hi(u0.w);
        c[0] = pg8::bf_lo(u1.x); c[1] = pg8::bf_hi(u1.x); c[2] = pg8::bf_lo(u1.y); c[3] = pg8::bf_hi(u1.y); d[0] = pg8::bf_lo(u1.z); d[1] = pg8::bf_hi(u1.z); d[2] = pg8::bf_lo(u1.w); d[3] = pg8::bf_hi(u1.w);
        LAS f32x4* dst = (LAS f32x4*)(US + lane * 16); dst[0] = a; dst[1] = b; dst[2] = c; dst[3] = d;
    }
}
DI void s5_stage_u(LAS float* US, const bf16* P0, int nrows, int lane) { v4u u0 = {0u, 0u, 0u, 0u}, u1 = {0u, 0u, 0u, 0u}; s5_stage_load(P0, nrows, lane, u0, u1); s5_stage_store(US, nrows, lane, u0, u1); }
DI void s5_step(const LAS float* urow  , const float (&bb)[32], float lre, float lim, float& hre, float& him) {
    const LAS f32x4* u4 = (const LAS f32x4*)urow; const f32x4 a = u4[0], b = u4[1], c = u4[2], d = u4[3];
    const float uf[16] = {a[0], a[1], a[2], a[3], b[0], b[1], b[2], b[3], c[0], c[1], c[2], c[3], d[0], d[1], d[2], d[3]};
    float dr[4] = {0.f, 0.f, 0.f, 0.f}, di[4] = {0.f, 0.f, 0.f, 0.f};
#pragma unroll
    for (int k = 0; k < 16; ++k) { dr[k & 3] += bb[k] * uf[k]; di[k & 3] += bb[16 + k] * uf[k]; }
    const float dre = (dr[0] + dr[1]) + (dr[2] + dr[3]), dim = (di[0] + di[1]) + (di[2] + di[3]);
    const float nre = lre * hre - lim * him + dre, nim = lre * him + lim * hre + dim; hre = nre; him = nim;
}
DI void s5_prep_item(const Ctx& C0, int l, int item) {
    Ctx C = C0; C.tid = (int)threadIdx.x; C.lane = C.tid & 63; C.lds = lds_base(); asm volatile("" : "+v"(C.tid), "+v"(C.lane), "+v"(C.lds), "+s"(C.a), "+s"(C.ws), "+s"(C.out));
    const int g = item & 31, c = (item >> 5) & 31, b = item >> 10;
    LAS float* US = (LAS float*)(C.lds + C.wave * WAVE_LDS);
    float lre, lim, bb[32]; s5_load_consts(C, l, g, lre, lim, bb);
    s5_stage_u(US, WSP(bf16, WS_P) + (size_t)(b * SEQ + 64 * c) * LDP + C_S5U + g * 16, 64, C.lane);
    LDS_WAIT(); asm volatile("" ::: "memory");
    float hre = 0.f, him = 0.f;
#pragma unroll 8
    for (int t = 0; t < 64; ++t) s5_step(US + t * 16, bb, lre, lim, hre, him);
    f32x2 o; o.x = hre; o.y = him; *(f32x2*)(WSP(float, WS_LEND) + ((size_t)item * 64 + C.lane) * 2) = o;
    LDS_WAIT(); asm volatile("" ::: "memory");
}

DI void prep_phase(const Ctx& C, int l) {
    int oz = 0; asm volatile("" : "+s"(oz));
    for (int it = C.vcu + oz; it < 2304; it += C.G) {
        int n1 = (DUP_PHASE == 11) ? 2 : 1, n2 = (DUP_PHASE == 12) ? 2 : 1, n3 = (DUP_PHASE == 13) ? 2 : 1; asm volatile("" : "+s"(n1), "+s"(n2), "+s"(n3));
        if (it < 512) { for (int q = 0; q < n1; ++q) gdn_prep_item(C, l, it); }
        else if (it < 1024) { for (int q = 0; q < n2; ++q) ret_prep_item(C, l, it - 512); }
        else if (it < 1280) { for (int q = 0; q < n3; ++q) ssdg_prep_item(C, l, it - 1024); }
        else { for (int q = 0; q < n3; ++q) ssdh_prep_item(C, l, it - 1280); }
    }
    const int gw = C.vcu * NWAVES + C.wave + oz, NGW = C.G * NWAVES;
    { int n4 = (DUP_PHASE == 14) ? 2 : 1; asm volatile("" : "+s"(n4));
      for (int it = gw; it < 4 * 32 * 32; it += NGW) for (int q = 0; q < n4; ++q) s5_prep_item(C, l, it); }
}
#ifndef DUP_PHASE
#define DUP_PHASE -1
#endif
#ifndef OLD_DIST
#define OLD_DIST 0
#endif
#ifndef OLD_WALK
#define OLD_WALK 0
#endif
#ifndef EN_WALK
#define EN_WALK 255
#endif

template <typename T> DI T ldu(const void* ubase, unsigned loff, int cbytes) { return *(const T*)((const char*)ubase + cbytes + loff); }
template <typename T> DI void stu(void* ubase, unsigned loff, int cbytes, T v) { *(T*)((char*)ubase + cbytes + loff) = v; }
DI bf16x8 ldfu_nat(const void* ubase, unsigned loff, int cbytes) { return ldu<bf16x8>(ubase, loff, cbytes); }
DI bf16x8 ldfu_perm(const void* ubase, unsigned loff, int cbytes) { const s16x4 lo = ldu<s16x4>(ubase, loff, cbytes), hi = ldu<s16x4>(ubase, loff, cbytes + 16); return __builtin_shufflevector(lo, hi, 0, 1, 2, 3, 4, 5, 6, 7); }
constexpr int CR(int reg) { return (reg & 3) + 8 * (reg >> 2); }

DI void gdn_walk(const Ctx& C0, int l, int wi) {
    Ctx C = C0; C.tid = (int)threadIdx.x; C.lane = C.tid & 63; C.lds = lds_base(); asm volatile("" : "+v"(C.tid), "+v"(C.lane), "+v"(C.lds), "+s"(C.a), "+s"(C.ws), "+s"(C.out));
    const int slice = wi & 3, bh = wi >> 2, hh = bh & 3, b = bh >> 2, lane = C.lane, r = lane & 31, h = lane >> 5, dv0 = 32 * slice;
    const unsigned lo_a128 = (unsigned)(r * 128 + 4 * h) * 2u;
    const unsigned lo_a64 = (unsigned)(r * 64 + 4 * h) * 2u;
    const unsigned lo_u = (unsigned)(4 * h * 128 + dv0 + r) * 4u;
    const unsigned lo_g = (unsigned)(4 * h) * 4u;
    const unsigned lo_o = (unsigned)(4 * h * 1536 + hh * 128 + dv0 + r) * 4u;
    f32x16 S[4];
#pragma unroll
    for (int i = 0; i < 4; ++i) S[i] = zero16();
#pragma unroll 1
    for (int c = 0; c < NCH; ++c) {
        const size_t idx = (size_t)bh * 32 + c;
        const bf16* W = WSP(bf16, WS_GW) + idx * 8192; const bf16* Q = WSP(bf16, WS_GQ) + idx * 8192; const bf16* SC = WSP(bf16, WS_GSC) + idx * 4096; const bf16* KT = WSP(bf16, WS_GKT) + idx * 8192;
        const float* U = WSP(float, WS_GU) + idx * 8192; const float* G = WSP(float, WS_GG) + idx * 64;
        float* Oc = WSP(float, WS_O) + (size_t)(b * SEQ + 64 * c) * 1536;
        bf16x8 Sb[8];
#pragma unroll
        for (int dt = 0; dt < 4; ++dt) { Sb[2 * dt] = pack_step<0>(S[dt]); Sb[2 * dt + 1] = pack_step<1>(S[dt]); }
        f32x16 vn[2], o[2];
#pragma unroll
        for (int it = 0; it < 2; ++it) {
            f32x16 a = zero16(), q = zero16();
#pragma unroll
            for (int ks = 0; ks < 8; ++ks) {
                a = MFMA32(ldfu_perm(W, lo_a128, (32 * it * 128 + 16 * ks) * 2), Sb[ks], a);
                q = MFMA32(ldfu_perm(Q, lo_a128, (32 * it * 128 + 16 * ks) * 2), Sb[ks], q);
                if (ks & 1) __builtin_amdgcn_sched_barrier(0);
            }
#pragma unroll
            for (int reg = 0; reg < 16; ++reg) { vn[it][reg] = ldu<float>(U, lo_u, (32 * it + CR(reg)) * 128 * 4) - a[reg]; o[it][reg] = __expf(ldu<float>(G, lo_g, (32 * it + CR(reg)) * 4)) * q[reg]; }
            __builtin_amdgcn_sched_barrier(0);
        }
        bf16x8 vb[2][2]; vb[0][0] = pack_step<0>(vn[0]); vb[0][1] = pack_step<1>(vn[0]); vb[1][0] = pack_step<0>(vn[1]); vb[1][1] = pack_step<1>(vn[1]);
#pragma unroll
        for (int s = 0; s < 2; ++s) {
            o[0] = MFMA32(ldfu_perm(SC, lo_a64, (16 * s) * 2), vb[0][s], o[0]);
            o[1] = MFMA32(ldfu_perm(SC, lo_a64, (32 * 64 + 16 * s) * 2), vb[0][s], o[1]);
            o[1] = MFMA32(ldfu_perm(SC, lo_a64, (32 * 64 + 32 + 16 * s) * 2), vb[1][s], o[1]);
        }
        const float gl = __expf(ldu<float>(G, vzero(), 63 * 4));
#pragma unroll
        for (int dt = 0; dt < 4; ++dt) {
            S[dt] = S[dt] * gl;
#pragma unroll
            for (int it = 0; it < 2; ++it)
#pragma unroll
                for (int s = 0; s < 2; ++s) S[dt] = MFMA32(ldfu_perm(KT, lo_a64, (32 * dt * 64 + 32 * it + 16 * s) * 2), vb[it][s], S[dt]);
            if (dt & 1) __builtin_amdgcn_sched_barrier(0);
        }
#pragma unroll
        for (int it = 0; it < 2; ++it)
#pragma unroll
            for (int reg = 0; reg < 16; ++reg) stu<float>(Oc, lo_o, (32 * it + CR(reg)) * 1536 * 4, o[it][reg]);
    }
    float* so = C.out + O_PGDN + ((size_t)(l * 4 + b) * 4 + hh) * 128 * 128;
    const unsigned lo_s = (unsigned)(4 * h * 128 + dv0 + r) * 4u;
#pragma unroll
    for (int dt = 0; dt < 4; ++dt)
#pragma unroll
        for (int reg = 0; reg < 16; ++reg) stu<float>(so, lo_s, (32 * dt + CR(reg)) * 128 * 4, S[dt][reg]);
}

template <int DV> DI void la_walk(const Ctx& C, const bf16* Qb, const bf16* Kb, const bf16* KTb, const bf16* VTb, const bf16* VDb, const float* Gb, const float* DTb, int dv0,
                float* O  , float* so  ) {
    const int lane = C.lane, r = lane & 31, h = lane >> 5;
    const unsigned lo_n128 = (unsigned)(r * 128 + 8 * h) * 2u, lo_p128 = (unsigned)(r * 128 + 4 * h) * 2u;
    const unsigned lo_n64 = (unsigned)(r * 64 + 8 * h) * 2u;
    const unsigned lo_vn = (unsigned)((dv0 + r) * 64 + 8 * h) * 2u, lo_vp = (unsigned)((dv0 + r) * 64 + 4 * h) * 2u;
    const unsigned lo_g = (unsigned)(4 * h) * 4u, lo_gi = (unsigned)r * 4u;
    const unsigned lo_o = (unsigned)(4 * h * 1536 + dv0 + r) * 4u;
    f32x16 S[4];
#pragma unroll
    for (int i = 0; i < 4; ++i) S[i] = zero16();
#pragma unroll 1
    for (int c = 0; c < NCH; ++c) {
        const bf16* Q = Qb + (size_t)c * 8192; const bf16* K = Kb + (size_t)c * 8192; const bf16* KT = KTb + (size_t)c * 8192;
        const bf16* VT = VTb + (size_t)c * DV * 64; const bf16* VD = VDb + (size_t)c * DV * 64; const float* G = Gb + c * 64; const float* DT = DTb + c * 64;
        float* Oc = O + (size_t)(64 * c) * 1536;
        f32x16 s00 = zero16(), s01 = zero16(), s11 = zero16();
#pragma unroll
        for (int ks = 0; ks < 8; ++ks) {
            const bf16x8 k0 = ldfu_nat(K, lo_n128, (16 * ks) * 2), k1 = ldfu_nat(K, lo_n128, (32 * 128 + 16 * ks) * 2), q0 = ldfu_nat(Q, lo_n128, (16 * ks) * 2), q1 = ldfu_nat(Q, lo_n128, (32 * 128 + 16 * ks) * 2);
            s00 = MFMA32(k0, q0, s00); s01 = MFMA32(k0, q1, s01); s11 = MFMA32(k1, q1, s11);
            if (ks & 1) __builtin_amdgcn_sched_barrier(0);
        }
        const float Gi0 = ldu<float>(G, lo_gi, 0), Gi1 = ldu<float>(G, lo_gi, 32 * 4);
#pragma unroll
        for (int reg = 0; reg < 16; ++reg) { const int j0 = CR(reg) + 4 * h;
            const float Gj0 = ldu<float>(G, lo_g, CR(reg) * 4), Gj1 = ldu<float>(G, lo_g, (32 + CR(reg)) * 4), d0 = ldu<float>(DT, lo_g, CR(reg) * 4), d1 = ldu<float>(DT, lo_g, (32 + CR(reg)) * 4);
            s00[reg] = (r >= j0) ? s00[reg] * d0 * __expf(Gi0 - Gj0) : 0.f;
            s01[reg] = s01[reg] * d0 * __expf(Gi1 - Gj0);
            s11[reg] = (r >= j0) ? s11[reg] * d1 * __expf(Gi1 - Gj1) : 0.f; }
        __builtin_amdgcn_sched_barrier(0);
        f32x16 o0 = zero16(), o1 = zero16();
        { const bf16x8 p00a = pack_step<0>(s00), p00b = pack_step<1>(s00), p01a = pack_step<0>(s01), p01b = pack_step<1>(s01), p11a = pack_step<0>(s11), p11b = pack_step<1>(s11);
          const bf16x8 v00 = ldfu_perm(VT, lo_vp, 0), v01 = ldfu_perm(VT, lo_vp, 32), v10 = ldfu_perm(VT, lo_vp, 64), v11 = ldfu_perm(VT, lo_vp, 96);
          o0 = MFMA32(p00a, v00, o0); o0 = MFMA32(p00b, v01, o0);
          o1 = MFMA32(p01a, v00, o1); o1 = MFMA32(p01b, v01, o1); o1 = MFMA32(p11a, v10, o1); o1 = MFMA32(p11b, v11, o1); }
        __builtin_amdgcn_sched_barrier(0);
        {
            bf16x8 Sb[8];
#pragma unroll
            for (int dt = 0; dt < 4; ++dt) { Sb[2 * dt] = pack_step<0>(S[dt]); Sb[2 * dt + 1] = pack_step<1>(S[dt]); }
            f32x16 q0 = zero16(), q1 = zero16();
#pragma unroll
            for (int ks = 0; ks < 8; ++ks) { q0 = MFMA32(ldfu_perm(Q, lo_p128, (16 * ks) * 2), Sb[ks], q0); q1 = MFMA32(ldfu_perm(Q, lo_p128, (32 * 128 + 16 * ks) * 2), Sb[ks], q1); if ((ks & 3) == 3) __builtin_amdgcn_sched_barrier(0); }
#pragma unroll
            for (int reg = 0; reg < 16; ++reg) { o0[reg] += __expf(ldu<float>(G, lo_g, CR(reg) * 4)) * q0[reg]; o1[reg] += __expf(ldu<float>(G, lo_g, (32 + CR(reg)) * 4)) * q1[reg]; }
        }
        __builtin_amdgcn_sched_barrier(0);
        const float gl = __expf(ldu<float>(G, vzero(), 63 * 4));
        { const bf16x8 d0 = ldfu_nat(VD, lo_vn, 0), d1 = ldfu_nat(VD, lo_vn, 32), d2 = ldfu_nat(VD, lo_vn, 64), d3 = ldfu_nat(VD, lo_vn, 96);
#pragma unroll
          for (int dt = 0; dt < 4; ++dt) {
            S[dt] = S[dt] * gl;
            S[dt] = MFMA32(ldfu_nat(KT, lo_n64, (32 * dt * 64) * 2), d0, S[dt]); S[dt] = MFMA32(ldfu_nat(KT, lo_n64, (32 * dt * 64 + 16) * 2), d1, S[dt]);
            S[dt] = MFMA32(ldfu_nat(KT, lo_n64, (32 * dt * 64 + 32) * 2), d2, S[dt]); S[dt] = MFMA32(ldfu_nat(KT, lo_n64, (32 * dt * 64 + 48) * 2), d3, S[dt]); if (dt & 1) __builtin_amdgcn_sched_barrier(0); } }
#pragma unroll
        for (int reg = 0; reg < 16; ++reg) { stu<float>(Oc, lo_o, CR(reg) * 1536 * 4, o0[reg]); stu<float>(Oc, lo_o, (32 + CR(reg)) * 1536 * 4, o1[reg]); }
    }
    const unsigned lo_s = (unsigned)(4 * h * DV + dv0 + r) * 4u;
#pragma unroll
    for (int dt = 0; dt < 4; ++dt)
#pragma unroll
        for (int reg = 0; reg < 16; ++reg) stu<float>(so, lo_s, (32 * dt + CR(reg)) * DV * 4, S[dt][reg]);
}
DI void ret_walk(const Ctx& C0, int l, int wi) {
    Ctx C = C0; C.tid = (int)threadIdx.x; C.lane = C.tid & 63; C.lds = lds_base(); asm volatile("" : "+v"(C.tid), "+v"(C.lane), "+v"(C.lds), "+s"(C.a), "+s"(C.ws), "+s"(C.out));
    const int slice = wi & 3, bh = wi >> 2, hh = bh & 3, b = bh >> 2; const size_t i0 = (size_t)bh * 32;
    la_walk<128>(C, WSP(bf16, WS_RQ) + i0 * 8192, WSP(bf16, WS_RK) + i0 * 8192, WSP(bf16, WS_RKT) + i0 * 8192, WSP(bf16, WS_RVT) + i0 * 8192, WSP(bf16, WS_RVD) + i0 * 8192,
            WSP(float, WS_RG) + i0 * 64, WSP(float, WS_RDT) + i0 * 64, 32 * slice, WSP(float, WS_O) + (size_t)b * SEQ * 1536 + 1024 + hh * 128,
            C.out + O_PRET + ((size_t)(l * 4 + b) * 4 + hh) * 128 * 128);
}
DI void ssd_walk(const Ctx& C0, int l, int wi) {
    Ctx C = C0; C.tid = (int)threadIdx.x; C.lane = C.tid & 63; C.lds = lds_base(); asm volatile("" : "+v"(C.tid), "+v"(C.lane), "+v"(C.lds), "+s"(C.a), "+s"(C.ws), "+s"(C.out));
    const int slice = wi & 1, bh = wi >> 1, hh = bh & 7, b = bh >> 3; const size_t ig = (size_t)(b * 2 + (hh >> 2)) * 32, ih = (size_t)bh * 32;
    la_walk<64>(C, WSP(bf16, WS_SQ) + ig * 8192, WSP(bf16, WS_SK) + ig * 8192, WSP(bf16, WS_SKT) + ig * 8192, WSP(bf16, WS_SVT) + ih * 4096, WSP(bf16, WS_SVD) + ih * 4096,
            WSP(float, WS_SG) + ih * 64, WSP(float, WS_SDT) + ih * 64, 32 * slice, WSP(float, WS_O) + (size_t)b * SEQ * 1536 + 512 + hh * 64,
            C.out + O_PSSD + ((size_t)(l * 4 + b) * 8 + hh) * 128 * 64);
}

constexpr int HS_LD = 132;
DI void s5_load_cq(const Ctx& C, int l, int g, float (&cq)[32]) {
    const int ch = C.lane & 15, kq = C.lane >> 4;
    const float* cre = INP(I_S5CRE) + (((size_t)l * 32 + g) * 16 + ch) * 64 + kq; const float* cim = INP(I_S5CIM) + (((size_t)l * 32 + g) * 16 + ch) * 64 + kq;
#pragma unroll
    for (int kk = 0; kk < 16; ++kk) { cq[kk] = cre[4 * kk]; cq[16 + kk] = -cim[4 * kk]; }
}
DI void s5_project(const Ctx& C, const float (&cq)[32], const LAS float* HS, int nt  , const LAS float* US0  , const float* dvec  , bf16* Yrow0) {
    const int ch = C.lane & 15, kq = C.lane >> 4;
    f32x4 acc = {0.f, 0.f, 0.f, 0.f}, acc2 = {0.f, 0.f, 0.f, 0.f};
    const LAS float* hp = HS + ch * HS_LD + kq;
#pragma unroll
    for (int kk = 0; kk < 32; kk += 2) { acc = __builtin_amdgcn_mfma_f32_16x16x4f32(hp[4 * kk], cq[kk], acc, 0, 0, 0); acc2 = __builtin_amdgcn_mfma_f32_16x16x4f32(hp[4 * kk + 4], cq[kk + 1], acc2, 0, 0, 0); }
    acc = acc + acc2;
    const float dv = dvec[ch];
#pragma unroll
    for (int reg = 0; reg < 4; ++reg) { const int t = 4 * kq + reg;
        if (t < nt) Yrow0[(size_t)t * 512 + ch] = (bf16)f2bf(geluf(acc[reg] + dv * US0[t * 16 + ch])); }
}
DI void s5_walk_item(const Ctx& C0, int l, int item) {
    Ctx C = C0; C.tid = (int)threadIdx.x; C.lane = C.tid & 63; C.lds = lds_base(); asm volatile("" : "+v"(C.tid), "+v"(C.lane), "+v"(C.lds), "+s"(C.a), "+s"(C.ws), "+s"(C.out));
    const int g = item & 31, cq = (item >> 5) & 7, b = item >> 8, lane = C.lane;
    LAS float* HS = (LAS float*)(C.lds + C.wave * WAVE_LDS); LAS float* US = HS + 16 * HS_LD;
    float lre, lim, bb[32], cq_[32]; s5_load_consts(C, l, g, lre, lim, bb); s5_load_cq(C, l, g, cq_);
    float pre = lre, pim = lim;
#pragma unroll
    for (int i = 0; i < 6; ++i) { const float nr = pre * pre - pim * pim, ni = 2.f * pre * pim; pre = nr; pim = ni; }
    float hre = 0.f, him = 0.f;
    { const float* LE = WSP(float, WS_LEND) + ((size_t)(b * 32) * 32 + g) * 128 + lane * 2;
      for (int q = 0; q < cq; ++q) {
        f32x2 e[4];
#pragma unroll
        for (int i = 0; i < 4; ++i) e[i] = *(const f32x2*)(LE + (size_t)(4 * q + i) * 32 * 128);
#pragma unroll
        for (int i = 0; i < 4; ++i) { const float nr = pre * hre - pim * him + e[i].x, ni = pre * him + pim * hre + e[i].y; hre = nr; him = ni; } } }
    const float* dvec = INP(I_S5D) + (size_t)l * 512 + g * 16;
    v4u un0 = {0u, 0u, 0u, 0u}, un1 = {0u, 0u, 0u, 0u};
    s5_stage_load(WSP(bf16, WS_P) + (size_t)(b * SEQ + 64 * (4 * cq)) * LDP + C_S5U + g * 16, 64, lane, un0, un1);
#pragma unroll 1
    for (int cc = 0; cc < 4; ++cc) { const int c = 4 * cq + cc;
        s5_stage_store(US, 64, lane, un0, un1);
        if (cc < 3) s5_stage_load(WSP(bf16, WS_P) + (size_t)(b * SEQ + 64 * (c + 1)) * LDP + C_S5U + g * 16, 64, lane, un0, un1);
        bf16* Y = WSP(bf16, WS_YS5) + (size_t)(b * SEQ + 64 * c) * 512 + g * 16;
        LDS_WAIT(); asm volatile("" ::: "memory");
        for (int sub = 0; sub < 4; ++sub) {
#pragma unroll
            for (int t = 0; t < 16; ++t) { s5_step(US + (16 * sub + t) * 16, bb, lre, lim, hre, him); HS[t * HS_LD + lane] = hre; HS[t * HS_LD + 64 + lane] = him; }
            LDS_WAIT(); asm volatile("" ::: "memory");
            s5_project(C, cq_, HS, 16, US + (16 * sub) * 16, dvec, Y + (size_t)(16 * sub) * 512);
            LDS_WAIT(); asm volatile("" ::: "memory");
        }
    }
    if (cq == 7) { C.out[O_PS5RE + ((size_t)(l * 4 + b) * 32 + g) * 64 + lane] = hre; C.out[O_PS5IM + ((size_t)(l * 4 + b) * 32 + g) * 64 + lane] = him; }
}
DI void s5_sample_item(const Ctx& C0, int l, int item) {
    Ctx C = C0; C.tid = (int)threadIdx.x; C.lane = C.tid & 63; C.lds = lds_base(); asm volatile("" : "+v"(C.tid), "+v"(C.lane), "+v"(C.lds), "+s"(C.a), "+s"(C.ws), "+s"(C.out));
    const int g = item & 31, b4 = item >> 5, lane = C.lane;
    LAS float* HS = (LAS float*)(C.lds + C.wave * WAVE_LDS); LAS float* US = HS + 16 * HS_LD;
    float lre, lim, bb[32], cq_[32]; s5_load_consts(C, l, g, lre, lim, bb); s5_load_cq(C, l, g, cq_);
#pragma unroll
    for (int t = ST; t < 16; ++t) { HS[t * HS_LD + lane] = 0.f; HS[t * HS_LD + 64 + lane] = 0.f; }
#pragma unroll 1
    for (int bi = 0; bi < 4; ++bi) { const int b = 4 * b4 + bi;
        s5_stage_u(US, WSP(bf16, WS_P) + (size_t)(MP + b * ST) * LDP + C_S5U + g * 16, ST, lane);
        const size_t si = ((size_t)(l * SB + b) * 32 + g) * 64 + lane;
        float hre = INP(I_S5RE)[si], him = INP(I_S5IM)[si];
        LDS_WAIT(); asm volatile("" ::: "memory");
#pragma unroll
        for (int t = 0; t < ST; ++t) { s5_step(US + t * 16, bb, lre, lim, hre, him); HS[t * HS_LD + lane] = hre; HS[t * HS_LD + 64 + lane] = him; }
        LDS_WAIT(); asm volatile("" ::: "memory");
        s5_project(C, cq_, HS, ST, US, INP(I_S5D) + (size_t)l * 512 + g * 16, WSP(bf16, WS_YS5) + (size_t)(MP + b * ST) * 512 + g * 16);
        LDS_WAIT(); asm volatile("" ::: "memory");
        C.out[O_SS5RE + si] = hre; C.out[O_SS5IM + si] = him;
    }
}

DI void sconv4(const bf16* Prow0, int col, const float* buf  , int CW, int chn, const float* cw, float bias, float* outbuf  , float (&y)[4]) {
    float x[7];
    x[0] = buf[chn]; x[1] = buf[CW + chn]; x[2] = buf[2 * CW + chn];
#pragma unroll
    for (int t = 0; t < 4; ++t) x[3 + t] = bf2f(Prow0[(size_t)t * LDP + col]);
    const float w0 = cw[chn], w1 = cw[CW + chn], w2 = cw[2 * CW + chn], w3 = cw[3 * CW + chn];
#pragma unroll
    for (int t = 0; t < 4; ++t) y[t] = siluf(w0 * x[t] + w1 * x[t + 1] + w2 * x[t + 2] + w3 * x[t + 3] + bias);
    if (outbuf) { outbuf[chn] = x[4]; outbuf[CW + chn] = x[5]; outbuf[2 * CW + chn] = x[6]; }
}
template <bool GDN> DI void sample_core(const LAS float* QS, const LAS float* KS, const LAS float* VS, const LAS float* AB, int DV, const float* S0, float* S1, float* O  , int lane) {
    const int c32 = lane & 31, hf = lane >> 5;
    for (int pass = 0; pass < DV / 32; ++pass) {
        const int col = pass * 32 + c32;
        float s[64];
#pragma unroll
        for (int d = 0; d < 64; ++d) s[d] = __builtin_nontemporal_load(S0 + (size_t)(hf * 64 + d) * DV + col);
#pragma unroll 1
        for (int t = 0; t < 4; ++t) {
            const float a = AB[2 * t], beta = AB[2 * t + 1];
            const LAS float* kp = KS + t * 128 + hf * 64; const LAS float* qp = QS + t * 128 + hf * 64;
            float cv = VS[t * DV + col];
            if (GDN) {
                float kS = 0.f;
#pragma unroll
                for (int q = 0; q < 16; ++q) { const f32x4 kv = *(const LAS f32x4*)(kp + 4 * q); kS += (kv[0] * s[4 * q] + kv[1] * s[4 * q + 1]) + (kv[2] * s[4 * q + 2] + kv[3] * s[4 * q + 3]); if ((q & 3) == 3) __builtin_amdgcn_sched_barrier(0); }
                kS = pg8::xor32_sum(kS);
                cv = beta * (cv - a * kS);
            }
            float o = 0.f;
#pragma unroll
            for (int q = 0; q < 16; ++q) { const f32x4 kv = *(const LAS f32x4*)(kp + 4 * q), qv = *(const LAS f32x4*)(qp + 4 * q);
#pragma unroll
                for (int e = 0; e < 4; ++e) { s[4 * q + e] = a * s[4 * q + e] + cv * kv[e]; o += qv[e] * s[4 * q + e]; }
                if ((q & 3) == 3) __builtin_amdgcn_sched_barrier(0); }
            o = pg8::xor32_sum(o);
            if (hf == 0) O[(size_t)t * 1536 + col] = o;
        }
#pragma unroll
        for (int d = 0; d < 64; ++d) __builtin_nontemporal_store(s[d], S1 + (size_t)(hf * 64 + d) * DV + col);
    }
}
DI void gdn_sample_item(const Ctx& C0, int l, int item) {
    Ctx C = C0; C.tid = (int)threadIdx.x; C.lane = C.tid & 63; C.lds = lds_base(); asm volatile("" : "+v"(C.tid), "+v"(C.lane), "+v"(C.lds), "+s"(C.a), "+s"(C.ws), "+s"(C.out));
    const int hh = item & 3, b = item >> 2, lane = C.lane, row0 = MP + b * ST;
    LAS float* QS = (LAS float*)(C.lds + C.wave * WAVE_LDS); LAS float* KS = QS + 512; LAS float* VS = KS + 512; LAS float* AB = VS + 512;
    const bf16* Prow0 = WSP(bf16, WS_P) + (size_t)row0 * LDP;
    const float* buf = INP(I_SGDNC) + (size_t)(l * SB + b) * 3 * 1536; float* obuf = C.out + O_SGDNC + (size_t)(l * SB + b) * 3 * 1536; const float* cw = INP(I_GCW) + (size_t)l * 4 * 1536;
    {
#pragma unroll
        for (int k = 0; k < 2; ++k) { const int d = k * 64 + lane; float y[4]; sconv4(Prow0, C_GV + hh * 128 + d, buf, 1536, 1024 + hh * 128 + d, cw, 0.f, obuf, y);
#pragma unroll
            for (int t = 0; t < 4; ++t) VS[t * 128 + d] = y[t]; }
    }
#pragma unroll
    for (int arr = 0; arr < 2; ++arr) {
        float y0[4], y1[4];
        sconv4(Prow0, (arr == 0 ? C_GQ : C_GK) + hh * 128 + lane, buf, 1536, arr * 512 + hh * 128 + lane, cw, 0.f, obuf, y0);
        sconv4(Prow0, (arr == 0 ? C_GQ : C_GK) + hh * 128 + 64 + lane, buf, 1536, arr * 512 + hh * 128 + 64 + lane, cw, 0.f, obuf, y1);
        LAS float* dst = arr == 0 ? QS : KS;
#pragma unroll
        for (int t = 0; t < 4; ++t) { const float sc = rsqrtf(wave_sum(y0[t] * y0[t] + y1[t] * y1[t]) + EPS) * (arr == 0 ? 0.08838834764831845f : 1.f); dst[t * 128 + lane] = y0[t] * sc; dst[t * 128 + 64 + lane] = y1[t] * sc; }
    }
    if (lane < 4) { const float* ps = WSP(float, WS_PS) + (size_t)(row0 + lane) * 16;
        AB[2 * lane] = __expf(-__expf(INP(I_GALOG)[l * 4 + hh]) * softplusf(ps[4 + hh] + INP(I_GDTB)[l * 4 + hh])); AB[2 * lane + 1] = sigm(ps[hh]); }
    LDS_WAIT(); asm volatile("" ::: "memory");
    sample_core<true>(QS, KS, VS, AB, 128, INP(I_SGDN) + ((size_t)(l * SB + b) * 4 + hh) * 128 * 128, C.out + O_SGDN + ((size_t)(l * SB + b) * 4 + hh) * 128 * 128,
                      WSP(float, WS_O) + (size_t)row0 * 1536 + hh * 128, lane);
    LDS_WAIT(); asm volatile("" ::: "memory");
}
DI void ret_sample_item(const Ctx& C0, int l, int item) {
    Ctx C = C0; C.tid = (int)threadIdx.x; C.lane = C.tid & 63; C.lds = lds_base(); asm volatile("" : "+v"(C.tid), "+v"(C.lane), "+v"(C.lds), "+s"(C.a), "+s"(C.ws), "+s"(C.out));
    const int hh = item & 3, b = item >> 2, lane = C.lane, row0 = MP + b * ST;
    LAS float* QS = (LAS float*)(C.lds + C.wave * WAVE_LDS); LAS float* KS = QS + 512; LAS float* VS = KS + 512; LAS float* AB = VS + 512;
    const bf16* Prow0 = WSP(bf16, WS_P) + (size_t)row0 * LDP; const float* ROT = WSP(float, WS_ROT) + (size_t)2048 * 64 * 2;
#pragma unroll
    for (int t = 0; t < 4; ++t) { const f32x2 cs = *(const f32x2*)(ROT + ((size_t)t * 64 + lane) * 2); const bf16* pr = Prow0 + (size_t)t * LDP + hh * 128;
        const float q1 = bf2f(pr[C_RQ + lane]), q2 = bf2f(pr[C_RQ + 64 + lane]), k1 = bf2f(pr[C_RK + lane]), k2 = bf2f(pr[C_RK + 64 + lane]);
        QS[t * 128 + lane] = q1 * cs.x - q2 * cs.y; QS[t * 128 + 64 + lane] = q1 * cs.y + q2 * cs.x;
        KS[t * 128 + lane] = (k1 * cs.x - k2 * cs.y) * 0.08838834764831845f; KS[t * 128 + 64 + lane] = (k1 * cs.y + k2 * cs.x) * 0.08838834764831845f;
        VS[t * 128 + lane] = bf2f(pr[C_RV + lane]); VS[t * 128 + 64 + lane] = bf2f(pr[C_RV + 64 + lane]); }
    if (lane < 4) { const float dg = hh == 0 ? 0.96875f : hh == 1 ? 0.984375f : hh == 2 ? 0.9921875f : 0.99609375f;     AB[2 * lane] = dg; AB[2 * lane + 1] = 0.f; }
    LDS_WAIT(); asm volatile("" ::: "memory");
    sample_core<false>(QS, KS, VS, AB, 128, INP(I_SRET) + ((size_t)(l * SB + b) * 4 + hh) * 128 * 128, C.out + O_SRET + ((size_t)(l * SB + b) * 4 + hh) * 128 * 128,
                       WSP(float, WS_O) + (size_t)row0 * 1536 + 1024 + hh * 128, lane);
    LDS_WAIT(); asm volatile("" ::: "memory");
}
DI void ssd_sample_item(const Ctx& C0, int l, int item) {
    Ctx C = C0; C.tid = (int)threadIdx.x; C.lane = C.tid & 63; C.lds = lds_base(); asm volatile("" : "+v"(C.tid), "+v"(C.lane), "+v"(C.lds), "+s"(C.a), "+s"(C.ws), "+s"(C.out));
    const int hh = item & 7, b = item >> 3, grp = hh >> 2, lane = C.lane, row0 = MP + b * ST;
    LAS float* CS = (LAS float*)(C.lds + C.wave * WAVE_LDS); LAS float* BS = CS + 512; LAS float* VS = BS + 512; LAS float* AB = VS + 512;
    const bf16* Prow0 = WSP(bf16, WS_P) + (size_t)row0 * LDP;
    const float* buf = INP(I_SSSDC) + (size_t)(l * SB + b) * 3 * 1024; float* obuf = C.out + O_SSSDC + (size_t)(l * SB + b) * 3 * 1024;
    const float* cw = INP(I_SCW) + (size_t)l * 4 * 1024; const float* cb = INP(I_SCB) + (size_t)l * 1024;
    float* ob_bc = (hh & 3) == 0 ? obuf : nullptr;
#pragma unroll
    for (int k = 0; k < 4; ++k) {
        const int arr = k >> 1, n = (k & 1) * 64 + lane, chn = 512 + arr * 256 + grp * 128 + n;
        float y[4]; sconv4(Prow0, C_XBC + chn, buf, 1024, chn, cw, cb[chn], ob_bc, y);
        LAS float* dst = arr == 0 ? BS : CS;
#pragma unroll
        for (int t = 0; t < 4; ++t) dst[t * 128 + n] = y[t];
    }
    { float xs[4]; const int chn = hh * 64 + lane; sconv4(Prow0, C_XBC + chn, buf, 1024, chn, cw, cb[chn], obuf, xs);
#pragma unroll
      for (int t = 0; t < 4; ++t) { const float dt = softplusf(WSP(float, WS_PS)[(size_t)(row0 + t) * 16 + 8 + hh + vzero()] + INP(I_SDTB)[l * 8 + hh]);
          VS[t * 64 + lane] = xs[t] * dt; WSP(bf16, WS_XS)[(size_t)(row0 + t) * 512 + hh * 64 + lane] = (bf16)f2bf(xs[t]);
          if (lane == 0) { AB[2 * t] = __expf(-__expf(INP(I_SALOG)[l * 8 + hh]) * dt); AB[2 * t + 1] = 0.f; } } }
    LDS_WAIT(); asm volatile("" ::: "memory");
    sample_core<false>(CS, BS, VS, AB, 64, INP(I_SSSD) + ((size_t)(l * SB + b) * 8 + hh) * 128 * 64, C.out + O_SSSD + ((size_t)(l * SB + b) * 8 + hh) * 128 * 64,
                       WSP(float, WS_O) + (size_t)row0 * 1536 + 512 + hh * 64, lane);
    LDS_WAIT(); asm volatile("" ::: "memory");
}

constexpr int LD128 = 136, LD64 = 72;
template <int NCHUNK> DI void ldg_chunks(v4u (&v)[NCHUNK], const bf16* src, int t2) {
#pragma unroll
    for (int i = 0; i < NCHUNK; ++i) v[i] = *(const v4u*)(src + (size_t)(t2 + 256 * i) * 8);
}
template <int NCHUNK, int COLS, int LD> DI void sts_chunks(const v4u (&v)[NCHUNK], LAS bf16* dst, int t2) {
#pragma unroll
    for (int i = 0; i < NCHUNK; ++i) { const int ch = t2 + 256 * i, row = ch / (COLS / 8), cc = ch % (COLS / 8); *(LAS v4u*)(dst + row * LD + cc * 8) = v[i]; }
}
DI bf16x8 lds_nat(const LAS bf16* p) { return *(const LAS bf16x8*)p; }
DI bf16x8 lds_perm(const LAS bf16* p) { const s16x4 lo = *(const LAS s16x4*)p, hi = *(const LAS s16x4*)(p + 8); return __builtin_shufflevector(lo, hi, 0, 1, 2, 3, 4, 5, 6, 7); }

constexpr int GB_W = 0, GB_Q = 64 * LD128 * 2, GB_SC = 2 * 64 * LD128 * 2, GB_KT = GB_SC + 64 * LD64 * 2, GB_G = GB_KT + 128 * LD64 * 2, GB_SIZE = GB_G + 256;
static_assert(2 * GB_SIZE <= MISC_OFF, "GDN walker LDS");
DI void gdn_walk_wg(const Ctx& C0, int l, int bh) {
    Ctx C = C0; C.tid = (int)threadIdx.x; C.lane = C.tid & 63; C.lds = lds_base(); asm volatile("" : "+v"(C.tid), "+v"(C.lane), "+v"(C.lds), "+s"(C.a), "+s"(C.ws), "+s"(C.out));
    const int lane = C.lane, r = lane & 31, h = lane >> 5, wave = C.wave, hh = bh & 3, b = bh >> 2, dv0 = 32 * wave;
    const bool walker = wave < 4;
    const size_t idx0 = (size_t)bh * 32;
    if (!walker) {
        const bf16* Wg = WSP(bf16, WS_GW) + idx0 * 8192; const bf16* Qg = WSP(bf16, WS_GQ) + idx0 * 8192; const bf16* SCg = WSP(bf16, WS_GSC) + idx0 * 4096; const bf16* KTg = WSP(bf16, WS_GKT) + idx0 * 8192;
        const float* Gg = WSP(float, WS_GG) + idx0 * 64;
        v4u w[4], q[4], sc[2], kt[4]; float gv = 0.f;
        { const int t2 = C.tid - 256; ldg_chunks<4>(w, Wg, t2); ldg_chunks<4>(q, Qg, t2); ldg_chunks<2>(sc, SCg, t2); ldg_chunks<4>(kt, KTg, t2); if (t2 < 64) gv = Gg[t2]; }
#pragma unroll 1
        for (int c = -1; c < NCH; ++c) {
            int t2 = C.tid - 256; asm volatile("" : "+v"(t2));
            if (c + 1 < NCH) {
                LAS unsigned char* Bn = C.lds + ((c + 1) & 1) * GB_SIZE;
                sts_chunks<4, 128, LD128>(w, (LAS bf16*)(Bn + GB_W), t2); sts_chunks<4, 128, LD128>(q, (LAS bf16*)(Bn + GB_Q), t2); sts_chunks<2, 64, LD64>(sc, (LAS bf16*)(Bn + GB_SC), t2); sts_chunks<4, 64, LD64>(kt, (LAS bf16*)(Bn + GB_KT), t2);
                if (t2 < 64) ((LAS float*)(Bn + GB_G))[t2] = gv;
            }
            if (c + 2 < NCH) { const size_t cn = (size_t)(c + 2);
                ldg_chunks<4>(w, Wg + cn * 8192, t2); ldg_chunks<4>(q, Qg + cn * 8192, t2); ldg_chunks<2>(sc, SCg + cn * 4096, t2); ldg_chunks<4>(kt, KTg + cn * 8192, t2); if (t2 < 64) gv = Gg[cn * 64 + t2]; }
            __syncthreads();
        }
    } else {
        const float* Ug = WSP(float, WS_GU) + idx0 * 8192;
        f32x16 S[4];
#pragma unroll
        for (int i = 0; i < 4; ++i) S[i] = zero16();
        const unsigned lo_u = (unsigned)(4 * h * 128 + dv0 + r) * 4u, lo_o = (unsigned)(4 * h * 1536 + hh * 128 + dv0 + r) * 4u;
        f32x16 vn[2];
#pragma unroll
        for (int it = 0; it < 2; ++it)
#pragma unroll
            for (int reg = 0; reg < 16; ++reg) vn[it][reg] = ldu<float>(Ug, lo_u, (32 * it + CR(reg)) * 128 * 4);
        __syncthreads();
#pragma unroll 1
        for (int c = 0; c < NCH; ++c) {
            LAS unsigned char* B = C.lds + (c & 1) * GB_SIZE;
            const LAS bf16* W = (const LAS bf16*)(B + GB_W) + r * LD128 + 4 * h; const LAS bf16* Q = (const LAS bf16*)(B + GB_Q) + r * LD128 + 4 * h;
            const LAS bf16* SC = (const LAS bf16*)(B + GB_SC) + r * LD64 + 4 * h; const LAS bf16* KT = (const LAS bf16*)(B + GB_KT) + r * LD64 + 4 * h;
            const LAS float* G = (const LAS float*)(B + GB_G) + 4 * h;
            float* Oc = WSP(float, WS_O) + (size_t)(b * SEQ + 64 * c) * 1536;
            f32x16 o[2];
            bf16x8 Sb[8];
#pragma unroll
            for (int dt = 0; dt < 4; ++dt) { Sb[2 * dt] = pack_step<0>(S[dt]); Sb[2 * dt + 1] = pack_step<1>(S[dt]); }
#pragma unroll
            for (int it = 0; it < 2; ++it) {
                f32x16 a = zero16(), q = zero16();
#pragma unroll
                for (int kh = 0; kh < 2; ++kh) {
                    bf16x8 wf[4], qf[4];
#pragma unroll
                    for (int k4 = 0; k4 < 4; ++k4) { wf[k4] = lds_perm(W + 32 * it * LD128 + 16 * (4 * kh + k4)); qf[k4] = lds_perm(Q + 32 * it * LD128 + 16 * (4 * kh + k4)); }
                    __builtin_amdgcn_sched_barrier(0);
#pragma unroll
                    for (int k4 = 0; k4 < 4; ++k4) { a = MFMA32(wf[k4], Sb[4 * kh + k4], a); q = MFMA32(qf[k4], Sb[4 * kh + k4], q); }
                    __builtin_amdgcn_sched_barrier(0);
                }
#pragma unroll
                for (int reg = 0; reg < 16; ++reg) { vn[it][reg] -= a[reg]; o[it][reg] = __expf(G[32 * it + CR(reg)]) * q[reg]; }
                __builtin_amdgcn_sched_barrier(0);
            }
            bf16x8 vb[2][2]; vb[0][0] = pack_step<0>(vn[0]); vb[0][1] = pack_step<1>(vn[0]); vb[1][0] = pack_step<0>(vn[1]); vb[1][1] = pack_step<1>(vn[1]);
            { bf16x8 sf[2][3];
#pragma unroll
              for (int s = 0; s < 2; ++s) { sf[s][0] = lds_perm(SC + 16 * s); sf[s][1] = lds_perm(SC + 32 * LD64 + 16 * s); sf[s][2] = lds_perm(SC + 32 * LD64 + 32 + 16 * s); }
              __builtin_amdgcn_sched_barrier(0);
#pragma unroll
              for (int s = 0; s < 2; ++s) { o[0] = MFMA32(sf[s][0], vb[0][s], o[0]); o[1] = MFMA32(sf[s][1], vb[0][s], o[1]); o[1] = MFMA32(sf[s][2], vb[1][s], o[1]); } }
            const float gl = __expf(G[63 - 4 * h]);
#pragma unroll
            for (int dp = 0; dp < 2; ++dp) {
                bf16x8 kf[2][2][2];
#pragma unroll
                for (int e = 0; e < 2; ++e)
#pragma unroll
                    for (int it = 0; it < 2; ++it)
#pragma unroll
                        for (int s = 0; s < 2; ++s) kf[e][it][s] = lds_perm(KT + 32 * (2 * dp + e) * LD64 + 32 * it + 16 * s);
                S[2 * dp] = S[2 * dp] * gl; S[2 * dp + 1] = S[2 * dp + 1] * gl;
                __builtin_amdgcn_sched_barrier(0);
#pragma unroll
                for (int it = 0; it < 2; ++it)
#pragma unroll
                    for (int s = 0; s < 2; ++s) { S[2 * dp] = MFMA32(kf[0][it][s], vb[it][s], S[2 * dp]); S[2 * dp + 1] = MFMA32(kf[1][it][s], vb[it][s], S[2 * dp + 1]); }
                __builtin_amdgcn_sched_barrier(0);
            }
#pragma unroll
            for (int it = 0; it < 2; ++it)
#pragma unroll
                for (int reg = 0; reg < 16; ++reg) stu<float>(Oc, lo_o, (32 * it + CR(reg)) * 1536 * 4, o[it][reg]);
            if (c + 1 < NCH) { const float* U = Ug + (size_t)(c + 1) * 8192;
#pragma unroll
                for (int it = 0; it < 2; ++it)
#pragma unroll
                    for (int reg = 0; reg < 16; ++reg) vn[it][reg] = ldu<float>(U, lo_u, (32 * it + CR(reg)) * 128 * 4); }
            __syncthreads();
        }
        float* so = C.out + O_PGDN + ((size_t)(l * 4 + b) * 4 + hh) * 128 * 128;
        const unsigned lo_s = (unsigned)(4 * h * 128 + dv0 + r) * 4u;
#pragma unroll
        for (int dt = 0; dt < 4; ++dt)
#pragma unroll
            for (int reg = 0; reg < 16; ++reg) stu<float>(so, lo_s, (32 * dt + CR(reg)) * 128 * 4, S[dt][reg]);
    }
}

constexpr int LB_Q = 0, LB_K = 64 * LD128 * 2, LB_KT = 2 * 64 * LD128 * 2, LB_SIZE = LB_KT + 128 * LD64 * 2, LV_VT = 2 * LB_SIZE, LV_VD = LV_VT + 128 * LD64 * 2, LV_G = LV_VD + 128 * LD64 * 2, LV_END = LV_G + 2 * 2 * 2 * 256;
static_assert(LV_END <= MISC_OFF, "LA walker LDS");
template <bool SSD> DI void la_walk_wg(const Ctx& C0, int l, int wg  ) {
    Ctx C = C0; C.tid = (int)threadIdx.x; C.lane = C.tid & 63; C.lds = lds_base(); asm volatile("" : "+v"(C.tid), "+v"(C.lane), "+v"(C.lds), "+s"(C.a), "+s"(C.ws), "+s"(C.out));
    const int lane = C.lane, r = lane & 31, h = lane >> 5, wave = C.wave;
    const bool walker = wave < 4;
    const int b = wg >> 2, grp = (wg >> 1) & 1, pair = wg & 1, hA = SSD ? grp * 4 + pair * 2 : (wg & 3);
    if (!walker) {
        const size_t ig = SSD ? (size_t)(b * 2 + grp) * 32 : (size_t)wg * 32, ihA = SSD ? (size_t)(b * 8 + hA) * 32 : (size_t)wg * 32;
        const bf16* Qg = SSD ? WSP(bf16, WS_SQ) + ig * 8192 : WSP(bf16, WS_RQ) + ig * 8192; const bf16* Kg = SSD ? WSP(bf16, WS_SK) + ig * 8192 : WSP(bf16, WS_RK) + ig * 8192;
        const bf16* KTg = SSD ? WSP(bf16, WS_SKT) + ig * 8192 : WSP(bf16, WS_RKT) + ig * 8192;
        const bf16* VTg = SSD ? WSP(bf16, WS_SVT) + ihA * 4096 : WSP(bf16, WS_RVT) + ihA * 8192; const bf16* VDg = SSD ? WSP(bf16, WS_SVD) + ihA * 4096 : WSP(bf16, WS_RVD) + ihA * 8192;
        const float* Gg = SSD ? WSP(float, WS_SG) + ihA * 64 : WSP(float, WS_RG) + ihA * 64; const float* DTg = SSD ? WSP(float, WS_SDT) + ihA * 64 : WSP(float, WS_RDT) + ihA * 64;
        v4u q[4], k[4], kt[4], vt[4], vd[4]; float gv = 0.f, dv = 0.f;
#define LA_LOAD_QK(cn) do { ldg_chunks<4>(q, Qg + (size_t)(cn) * 8192, t2); ldg_chunks<4>(k, Kg + (size_t)(cn) * 8192, t2); ldg_chunks<4>(kt, KTg + (size_t)(cn) * 8192, t2); \
            if (t2 < 128) { const int hd2 = t2 >> 6, j = t2 & 63; const bool ok = (hd2 == 0 || SSD); gv = ok ? Gg[(size_t)hd2 * 32 * 64 + (size_t)(cn) * 64 + j] : 0.f; dv = ok ? DTg[(size_t)hd2 * 32 * 64 + (size_t)(cn) * 64 + j] : 0.f; } } while (0)
#define LA_STORE_QK(cn) do { LAS unsigned char* Bn = C.lds + ((cn) & 1) * LB_SIZE; \
            sts_chunks<4, 128, LD128>(q, (LAS bf16*)(Bn + LB_Q), t2); sts_chunks<4, 128, LD128>(k, (LAS bf16*)(Bn + LB_K), t2); sts_chunks<4, 64, LD64>(kt, (LAS bf16*)(Bn + LB_KT), t2); \
            if (t2 < 128) { LAS float* Gn = (LAS float*)(C.lds + LV_G) + ((cn) & 1) * 128; Gn[t2] = gv; Gn[256 + t2] = dv; } } while (0)
#define LA_LOAD_V(cn) do { if (SSD) { ldg_chunks<2>(*(v4u(*)[2])&vt[0], VTg + (size_t)(cn) * 4096, t2); ldg_chunks<2>(*(v4u(*)[2])&vt[2], VTg + (size_t)32 * 4096 + (size_t)(cn) * 4096, t2); \
                                       ldg_chunks<2>(*(v4u(*)[2])&vd[0], VDg + (size_t)(cn) * 4096, t2); ldg_chunks<2>(*(v4u(*)[2])&vd[2], VDg + (size_t)32 * 4096 + (size_t)(cn) * 4096, t2); } \
            else { ldg_chunks<4>(vt, VTg + (size_t)(cn) * 8192, t2); ldg_chunks<4>(vd, VDg + (size_t)(cn) * 8192, t2); } } while (0)
#define LA_STORE_V() do { if (SSD) { sts_chunks<2, 64, LD64>(*(const v4u(*)[2])&vt[0], (LAS bf16*)(C.lds + LV_VT), t2); sts_chunks<2, 64, LD64>(*(const v4u(*)[2])&vt[2], (LAS bf16*)(C.lds + LV_VT) + 64 * LD64, t2); \
                                      sts_chunks<2, 64, LD64>(*(const v4u(*)[2])&vd[0], (LAS bf16*)(C.lds + LV_VD), t2); sts_chunks<2, 64, LD64>(*(const v4u(*)[2])&vd[2], (LAS bf16*)(C.lds + LV_VD) + 64 * LD64, t2); } \
            else { sts_chunks<4, 64, LD64>(vt, (LAS bf16*)(C.lds + LV_VT), t2); sts_chunks<4, 64, LD64>(vd, (LAS bf16*)(C.lds + LV_VD), t2); } } while (0)
        v4u* Pv = WSP(v4u, WS_MIX) + (size_t)((SSD ? 16 : 0) + wg) * 32 * 768;
#define LA_COMPUTE_P(cn) do { const int lw = wave - 4; if (lw < 3) { const LAS unsigned char* Bn = C.lds + ((cn) & 1) * LB_SIZE; \
            const LAS bf16* Kp = (const LAS bf16*)(Bn + LB_K) + r * LD128 + 8 * h + (lw == 2 ? 32 * LD128 : 0); const LAS bf16* Qp = (const LAS bf16*)(Bn + LB_Q) + r * LD128 + 8 * h + (lw == 0 ? 0 : 32 * LD128); \
            bf16x8 kf[8], qf[8];                              \
            _Pragma("unroll") for (int ks = 0; ks < 8; ++ks) { kf[ks] = lds_nat(Kp + 16 * ks); qf[ks] = lds_nat(Qp + 16 * ks); } \
            f32x16 sc = zero16(); \
            _Pragma("unroll") for (int ks = 0; ks < 8; ++ks) sc = MFMA32(kf[ks], qf[ks], sc); \
            _Pragma("unroll") for (int hd2 = 0; hd2 < (SSD ? 2 : 1); ++hd2) { const LAS float* Gh = (const LAS float*)(C.lds + LV_G) + ((cn) & 1) * 128 + hd2 * 64; const LAS float* DTh = Gh + 256; \
                const float Gi = Gh[(lw == 0 ? 0 : 32) + r]; f32x16 tt; \
                _Pragma("unroll") for (int reg = 0; reg < 16; ++reg) { const int j0 = CR(reg) + 4 * h, jj = (lw == 2 ? 32 : 0) + j0; const float v = sc[reg] * DTh[jj] * __expf(Gi - Gh[jj]); tt[reg] = (lw == 1 || r >= j0) ? v : 0.f; } \
                v4u* dst = Pv + ((size_t)(cn) * 2 + hd2) * 384 + (size_t)lw * 128 + lane; \
                dst[0] = __builtin_bit_cast(v4u, pack_step<0>(tt)); dst[64] = __builtin_bit_cast(v4u, pack_step<1>(tt)); } } } while (0)
        { int t2 = C.tid - 256; asm volatile("" : "+v"(t2));
          LA_LOAD_QK(0); LA_LOAD_V(0); LA_STORE_QK(0); LA_STORE_V(); LA_LOAD_QK(1); LA_LOAD_V(1); }
        __syncthreads();
        LA_COMPUTE_P(0); asm volatile("s_waitcnt vmcnt(0)" ::: "memory");
        __syncthreads();
#pragma unroll 1
        for (int c = 0; c < NCH; ++c) {
            int t2 = C.tid - 256; asm volatile("" : "+v"(t2));
            if (c + 1 < NCH) LA_STORE_QK(c + 1);
            if (c + 2 < NCH) LA_LOAD_QK(c + 2);
            __syncthreads();
            if (c + 1 < NCH) { LA_COMPUTE_P(c + 1); }
            asm volatile("s_waitcnt vmcnt(0)" ::: "memory");
            __syncthreads();
            if (c + 1 < NCH) LA_STORE_V();
            if (c + 2 < NCH) LA_LOAD_V(c + 2);
        }
#undef LA_LOAD_QK
#undef LA_STORE_QK
#undef LA_LOAD_V
#undef LA_STORE_V
#undef LA_COMPUTE_P
    } else {
        f32x16 S[4];
#pragma unroll
        for (int i = 0; i < 4; ++i) S[i] = zero16();
        const int hd = SSD ? (wave >> 1) & 1 : 0;
        const int ocol = SSD ? 512 + (hA + hd) * 64 + 32 * (wave & 1) : 1024 + hA * 128 + 32 * wave;
        const unsigned lo_o = (unsigned)(4 * h * 1536 + ocol + r) * 4u;
        const v4u* Pv = WSP(v4u, WS_MIX) + (size_t)((SSD ? 16 : 0) + wg) * 32 * 768;
        __syncthreads();
        __syncthreads();
#pragma unroll 1
        for (int c = 0; c < NCH; ++c) {
            LAS unsigned char* B = C.lds + (c & 1) * LB_SIZE;
            const LAS float* G = (const LAS float*)(C.lds + LV_G) + (c & 1) * 128 + hd * 64; const LAS float* DT = G + 256;
            v4u pp[6];
#pragma unroll
            for (int th = 0; th < 6; ++th) pp[th] = Pv[((size_t)c * 2 + hd) * 384 + th * 64 + lane];
            f32x16 q0 = zero16(), q1 = zero16();
            {
                const LAS bf16* Qp = (const LAS bf16*)(B + LB_Q) + r * LD128 + 4 * h;
                bf16x8 Sb[8];
#pragma unroll
                for (int dt = 0; dt < 4; ++dt) { Sb[2 * dt] = pack_step<0>(S[dt]); Sb[2 * dt + 1] = pack_step<1>(S[dt]); }
                bf16x8 qa[8], qb[8];
#pragma unroll
                for (int ks = 0; ks < 8; ++ks) { qa[ks] = lds_perm(Qp + 16 * ks); qb[ks] = lds_perm(Qp + 32 * LD128 + 16 * ks); }
                __builtin_amdgcn_sched_barrier(0);
#pragma unroll
                for (int ks = 0; ks < 8; ++ks) { q0 = MFMA32(qa[ks], Sb[ks], q0); q1 = MFMA32(qb[ks], Sb[ks], q1); }
                __builtin_amdgcn_sched_barrier(0);
#pragma unroll
                for (int reg = 0; reg < 16; ++reg) { q0[reg] *= __expf(G[CR(reg) + 4 * h]); q1[reg] *= __expf(G[32 + CR(reg) + 4 * h]); }
            }
            __syncthreads();
            {
                const LAS bf16* KT = (const LAS bf16*)(B + LB_KT) + r * LD64 + 8 * h;
                const LAS bf16* VTp = (const LAS bf16*)(C.lds + LV_VT) + (32 * wave + r) * LD64 + 4 * h; const LAS bf16* VDn = (const LAS bf16*)(C.lds + LV_VD) + (32 * wave + r) * LD64 + 8 * h;
                float* Oc = WSP(float, WS_O) + (size_t)(b * SEQ + 64 * c) * 1536;
                f32x16 o0 = q0, o1 = q1;
                { const bf16x8 p00a = __builtin_bit_cast(bf16x8, pp[0]), p00b = __builtin_bit_cast(bf16x8, pp[1]), p01a = __builtin_bit_cast(bf16x8, pp[2]), p01b = __builtin_bit_cast(bf16x8, pp[3]), p11a = __builtin_bit_cast(bf16x8, pp[4]), p11b = __builtin_bit_cast(bf16x8, pp[5]);
                  const bf16x8 v00 = lds_perm(VTp), v01 = lds_perm(VTp + 16), v10 = lds_perm(VTp + 32), v11 = lds_perm(VTp + 48);
                  o0 = MFMA32(p00a, v00, o0); o0 = MFMA32(p00b, v01, o0);
                  o1 = MFMA32(p01a, v00, o1); o1 = MFMA32(p01b, v01, o1); o1 = MFMA32(p11a, v10, o1); o1 = MFMA32(p11b, v11, o1); }
                __builtin_amdgcn_sched_barrier(0);
                const float gl = __expf(G[63]);
                { const bf16x8 d0 = lds_nat(VDn), d1 = lds_nat(VDn + 16), d2 = lds_nat(VDn + 32), d3 = lds_nat(VDn + 48);
#pragma unroll
                  for (int dp = 0; dp < 2; ++dp) {
                    bf16x8 kf[2][4];
#pragma unroll
                    for (int e = 0; e < 2; ++e)
#pragma unroll
                        for (int s4 = 0; s4 < 4; ++s4) kf[e][s4] = lds_nat(KT + 32 * (2 * dp + e) * LD64 + 16 * s4);
                    S[2 * dp] = S[2 * dp] * gl; S[2 * dp + 1] = S[2 * dp + 1] * gl;
                    __builtin_amdgcn_sched_barrier(0);
                    S[2 * dp] = MFMA32(kf[0][0], d0, S[2 * dp]); S[2 * dp + 1] = MFMA32(kf[1][0], d0, S[2 * dp + 1]); S[2 * dp] = MFMA32(kf[0][1], d1, S[2 * dp]); S[2 * dp + 1] = MFMA32(kf[1][1], d1, S[2 * dp + 1]);
                    S[2 * dp] = MFMA32(kf[0][2], d2, S[2 * dp]); S[2 * dp + 1] = MFMA32(kf[1][2], d2, S[2 * dp + 1]); S[2 * dp] = MFMA32(kf[0][3], d3, S[2 * dp]); S[2 * dp + 1] = MFMA32(kf[1][3], d3, S[2 * dp + 1]);
                    __builtin_amdgcn_sched_barrier(0); } }
#pragma unroll
                for (int reg = 0; reg < 16; ++reg) { stu<float>(Oc, lo_o, CR(reg) * 1536 * 4, o0[reg]); stu<float>(Oc, lo_o, (32 + CR(reg)) * 1536 * 4, o1[reg]); }
            }
            __syncthreads();
        }
        constexpr int DVH = SSD ? 64 : 128;
        float* so = SSD ? C.out + O_PSSD + ((size_t)(l * 4 + b) * 8 + hA + hd) * 128 * 64 : C.out + O_PRET + ((size_t)(l * 4 + b) * 4 + hA) * 128 * 128;
        const int scol = SSD ? 32 * (wave & 1) : 32 * wave;
        const unsigned lo_s = (unsigned)(4 * h * DVH + scol + r) * 4u;
#pragma unroll
        for (int dt = 0; dt < 4; ++dt)
#pragma unroll
            for (int reg = 0; reg < 16; ++reg) stu<float>(so, lo_s, (32 * dt + CR(reg)) * DVH * 4, S[dt][reg]);
    }
}

constexpr int NWALK_WG = 48;
DI void walk_phase(const Ctx& C, int l, int part = 3) {
#if OLD_DIST
    {
        const bool is_walker = (C.wave == 0 && C.vcu < 192);
        if (is_walker) { int wi = C.vcu; asm volatile("" : "+s"(wi)); if (wi < 64) gdn_walk(C, l, wi); else if (wi < 128) ret_walk(C, l, wi - 64); else ssd_walk(C, l, wi - 128); return; }
        int oz = 0; asm volatile("" : "+s"(oz));
        const int nwalk_before = C.vcu < 192 ? C.vcu + 1 : 192;
        const int gw = C.vcu * NWAVES + C.wave - nwalk_before + oz, NGW = C.G * NWAVES - 192;
        constexpr int N_GS = SB * 4, N_RS = SB * 4, N_SS = SB * 8, N_S5W = 4 * 8 * 32, N_S5S = (SB / 4) * 32, TOT = N_GS + N_RS + N_SS + N_S5W + N_S5S;
        for (int it = gw; it < TOT; it += NGW) {
            int r = it;
            if (r < N_GS) { gdn_sample_item(C, l, r); continue; } r -= N_GS;
            if (r < N_RS) { ret_sample_item(C, l, r); continue; } r -= N_RS;
            if (r < N_SS) { ssd_sample_item(C, l, r); continue; } r -= N_SS;
            if (r < N_S5W) { s5_walk_item(C, l, r); continue; } r -= N_S5W;
            s5_sample_item(C, l, r);
        }
        return;
    }
#endif
    const int bxw = (int)blockIdx.x;
    if (bxw < NWALK_WG) {
        if (!(part & 1)) return;
        int wi = bxw; asm volatile("" : "+s"(wi));
        if ((part & 4) && wi >= 16) return;
        if ((part & 8) && wi < 16) return;
        if (wi < 16) { if (OLD_WALK & 1) { if (C.wave < 4) gdn_walk(C, l, wi * 4 + C.wave); } else gdn_walk_wg(C, l, wi); }
        else if (wi < 32) { if (OLD_WALK & 2) { if (C.wave < 4) ret_walk(C, l, (wi - 16) * 4 + C.wave); } else la_walk_wg<false>(C, l, wi - 16); }
        else { if (OLD_WALK & 4) { if (C.wave < 4) { const int g2 = wi - 32, bb = g2 >> 2, hA = ((g2 >> 1) & 1) * 4 + (g2 & 1) * 2; ssd_walk(C, l, ((bb * 8 + hA + (C.wave >> 1)) * 2) + (C.wave & 1)); } } else la_walk_wg<true>(C, l, wi - 32); }
        return;
    }
    if (!(part & 2)) return;
    int oz = 0; asm volatile("" : "+s"(oz));
    const int gw = (bxw - NWALK_WG) * NWAVES + C.wave + oz, NGW = (C.G - NWALK_WG) * NWAVES;
    constexpr int N_GS = SB * 4, N_RS = SB * 4, N_SS = SB * 8, N_S5W = 4 * 8 * 32, N_S5S = (SB / 4) * 32, N_SMALL = N_GS + N_RS + N_SS + N_S5S;
    if (NGW > N_S5W + 64 && (C.G - NWALK_WG) * 5 >= N_S5W) {
        const int wgi = bxw - NWALK_WG;
        if (C.wave < 5) { const int gw5 = wgi * 5 + C.wave + oz; if (gw5 < N_S5W) { s5_walk_item(C, l, gw5); s5_sample_item(C, l, gw5); } return; }
        const int g3 = wgi * 3 + (C.wave - 5) + oz, NG3 = (C.G - NWALK_WG) * 3;
        for (int it = g3; it < N_SMALL - N_S5S; it += NG3) {
            int r = it;
            if (r < N_GS) { gdn_sample_item(C, l, r); continue; } r -= N_GS;
            if (r < N_RS) { ret_sample_item(C, l, r); continue; } r -= N_RS;
            ssd_sample_item(C, l, r);
        }
        return;
    }
    for (int it = gw; it < N_SMALL + N_S5W; it += NGW) {
        int r = it;
        if (r < N_GS) { gdn_sample_item(C, l, r); continue; } r -= N_GS;
        if (r < N_RS) { ret_sample_item(C, l, r); continue; } r -= N_RS;
        if (r < N_SS) { ssd_sample_item(C, l, r); continue; } r -= N_SS;
        if (r < N_S5W) { s5_walk_item(C, l, r); continue; } r -= N_S5W;
        s5_sample_item(C, l, r);
    }
}

DI void post_rows(const Ctx& C0, int l, int wg0  ) {
    Ctx C = C0; C.tid = (int)threadIdx.x; C.lane = C.tid & 63; C.lds = lds_base(); asm volatile("" : "+v"(C.tid), "+v"(C.lane), "+v"(C.lds), "+s"(C.a), "+s"(C.ws), "+s"(C.out));
    int oz = 0; asm volatile("" : "+s"(oz));
    const int bxr = (int)blockIdx.x;
    if (bxr < wg0) return;
    const int gw = (bxr - wg0) * NWAVES + C.wave + oz, NGW = (C.G - wg0) * NWAVES, lane = C.lane;
    const float* O = WSP(float, WS_O); const bf16* P = WSP(bf16, WS_P); bf16* MIX = WSP(bf16, WS_MIX); const bf16* XS = WSP(bf16, WS_XS);
    const float* gnw = INP(I_GNW) + (size_t)l * 128; const float* snw = INP(I_SNW) + (size_t)l * 512; const float* sd = INP(I_SD) + (size_t)l * 8;
    const float* rlw = INP(I_RLW) + (size_t)l * 512; const float* rlb = INP(I_RLB) + (size_t)l * 512;
    for (int row = gw; row < M; row += NGW) {
        const float* o = O + (size_t)row * 1536; const bf16* p = P + (size_t)row * LDP; bf16* mx = MIX + (size_t)row * DM;
        f32x2 og[4], orr[4]; unsigned zg[4], gr[4]; f32x4 os[2]; v2u xw[2], zs[2];
#pragma unroll
        for (int hh = 0; hh < 4; ++hh) { og[hh] = *(const f32x2*)(o + hh * 128 + 2 * lane); zg[hh] = *(const unsigned*)(p + C_GZ + hh * 128 + 2 * lane);
            orr[hh] = *(const f32x2*)(o + 1024 + hh * 128 + 2 * lane); gr[hh] = *(const unsigned*)(p + C_RG + hh * 128 + 2 * lane); }
#pragma unroll
        for (int grp = 0; grp < 2; ++grp) { const int ch = grp * 256 + 4 * lane; os[grp] = *(const f32x4*)(o + 512 + ch); xw[grp] = *(const v2u*)(XS + (size_t)row * 512 + ch); zs[grp] = *(const v2u*)(p + C_CZ + ch); }
#pragma unroll
        for (int hh = 0; hh < 4; ++hh) {
            const f32x2 v = og[hh]; const float rs = rsqrtf(wave_sum(v.x * v.x + v.y * v.y) * (1.f / 128.f) + EPS);
            const unsigned zw = zg[hh]; const f32x2 w = *(const f32x2*)(gnw + 2 * lane);
            *(unsigned*)(mx + 512 + hh * 128 + 2 * lane) = pk2(v.x * rs * w.x * siluf(pg8::bf_lo(zw)), v.y * rs * w.y * siluf(pg8::bf_hi(zw)));
        }
#pragma unroll
        for (int grp = 0; grp < 2; ++grp) {
            const int ch = grp * 256 + 4 * lane; const f32x4 y = os[grp]; const v2u xv = xw[grp]; const v2u zw = zs[grp];
            const float D = sd[ch >> 6];
            f32x4 t; t[0] = (y[0] + pg8::bf_lo(xv.x) * D) * siluf(pg8::bf_lo(zw.x)); t[1] = (y[1] + pg8::bf_hi(xv.x) * D) * siluf(pg8::bf_hi(zw.x));
            t[2] = (y[2] + pg8::bf_lo(xv.y) * D) * siluf(pg8::bf_lo(zw.y)); t[3] = (y[3] + pg8::bf_hi(xv.y) * D) * siluf(pg8::bf_hi(zw.y));
            const float rs = rsqrtf(wave_sum((t[0] * t[0] + t[1] * t[1]) + (t[2] * t[2] + t[3] * t[3])) * (1.f / 256.f) + EPS); const f32x4 w = *(const f32x4*)(snw + ch);
            v2u ow; ow.x = pk2(t[0] * rs * w[0], t[1] * rs * w[1]); ow.y = pk2(t[2] * rs * w[2], t[3] * rs * w[3]); *(v2u*)(mx + 1024 + ch) = ow;
        }
#pragma unroll
        for (int hh = 0; hh < 4; ++hh) {
            const int ch = hh * 128 + 2 * lane; const f32x2 v = orr[hh]; const float mu = wave_sum(v.x + v.y) * (1.f / 128.f);
            const float d0 = v.x - mu, d1 = v.y - mu; const float rs = rsqrtf(wave_sum(d0 * d0 + d1 * d1) * (1.f / 128.f) + EPS);
            const unsigned gwd = gr[hh]; const f32x2 w = *(const f32x2*)(rlw + ch), bb = *(const f32x2*)(rlb + ch);
            *(unsigned*)(mx + 1536 + ch) = pk2((d0 * rs * w.x + bb.x) * siluf(pg8::bf_lo(gwd)), (d1 * rs * w.y + bb.y) * siluf(pg8::bf_hi(gwd)));
        }
    }
}
DI void final_rows(const Ctx& C0) {
    Ctx C = C0; C.tid = (int)threadIdx.x; C.lane = C.tid & 63; C.lds = lds_base(); asm volatile("" : "+v"(C.tid), "+v"(C.lane), "+v"(C.lds), "+s"(C.a), "+s"(C.ws), "+s"(C.out));
    const int gw = C.vcu * NWAVES + C.wave, NGW = C.G * NWAVES, lane = C.lane;
    const bf16* XB = WSP(bf16, WS_XB); const ull* ssq = WSP(ull, SSQ_OFF) + (size_t)6 * M; const float* nf = INP(I_NFIN);
    for (int row0 = gw; row0 < MP; row0 += 2 * NGW) {
        v2u hw[2][8]; float rs[2];
#pragma unroll
        for (int r = 0; r < 2; ++r) { const int row = row0 + r * NGW; rs[r] = pg8::rs_from_ssq(ssq, (row < MP ? row : row0) + (int)vzero());
#pragma unroll
            for (int j = 0; j < 8; ++j) hw[r][j] = *(const v2u*)(XB + (size_t)(row < MP ? row : row0) * DM + 256 * j + 4 * lane); }
#pragma unroll
        for (int r = 0; r < 2; ++r) { const int row = row0 + r * NGW; if (row < MP) {
#pragma unroll
            for (int j = 0; j < 8; ++j) { const f32x4 w = *(const f32x4*)(nf + 256 * j + 4 * lane);
                f32x4 v; v[0] = pg8::bf_lo(hw[r][j].x); v[1] = pg8::bf_hi(hw[r][j].x); v[2] = pg8::bf_lo(hw[r][j].y); v[3] = pg8::bf_hi(hw[r][j].y); __builtin_nontemporal_store(v * rs[r] * w, (f32x4*)(C.out + (size_t)row * DM + 256 * j + 4 * lane)); } } }
    }
}

typedef _Float16 f16x4 __attribute__((ext_vector_type(4)));
DI f32x4 ld_h4(const unsigned short* p) { const f16x4 h = *(const f16x4*)p; return __builtin_convertvector(h, f32x4); }
DI void sample_reduce(const Ctx& C0, int mode, int NS, const float* base  , ull* ssq_out, const ull* ssq_in, bf16* XO, int wg0, int nwg, unsigned* flag) {
    Ctx C = C0; C.tid = (int)threadIdx.x; C.lane = C.tid & 63; C.lds = lds_base(); asm volatile("" : "+v"(C.tid), "+v"(C.lane), "+v"(C.lds), "+s"(C.a), "+s"(C.ws), "+s"(C.out));
    int oz = 0; asm volatile("" : "+s"(oz));
    const int gw = ((int)blockIdx.x - wg0) * NWAVES + C.wave + oz, NGW = nwg * NWAVES, lane = C.lane;
    const unsigned short* SL = WSP(unsigned short, WS_O); float* H = WSP(float, WS_H); const bf16* PP = WSP(bf16, WS_PP);
    for (int rr = gw; rr < MS; rr += NGW) {
        const int row = MP + rr; float ss = 0.f;
        const float rs = mode ? pg8::rs_from_ssq(ssq_in, row + (int)vzero()) : 1.f;
#pragma unroll 2
        for (int j = 0; j < 8; ++j) { const int col = 256 * j + 4 * lane;
            f32x4 a = {0.f, 0.f, 0.f, 0.f};
            for (int sl = 0; sl < NS; ++sl) a += ld_h4(SL + ((size_t)sl * 512 + rr) * 2048 + col);
            f32x4 o;
            if (mode == 0) { o = *(const f32x4*)(base + (size_t)rr * DM + col) + a; }
            else { const f32x4 hv = *(const f32x4*)(H + (size_t)row * DM + col); const v2u pw = *(const v2u*)(PP + (size_t)row * DM + col); a = a * rs;
                o[0] = hv[0] + sigm(a[0]) * pg8::bf_lo(pw.x); o[1] = hv[1] + sigm(a[1]) * pg8::bf_hi(pw.x); o[2] = hv[2] + sigm(a[2]) * pg8::bf_lo(pw.y); o[3] = hv[3] + sigm(a[3]) * pg8::bf_hi(pw.y); }
            *(f32x4*)(H + (size_t)row * DM + col) = o;
            ss += (o[0] * o[0] + o[1] * o[1]) + (o[2] * o[2] + o[3] * o[3]);
            v2u x; x.x = pk2(o[0], o[1]); x.y = pk2(o[2], o[3]); *(v2u*)(XO + (size_t)row * DM + col) = x;
        }
        ss = wave_sum(ss);
        if (lane == 0) ssq_out[row] = (ull)(ss * pg8::SSQ_SCALE + 0.5f);
    }
    asm volatile("s_waitcnt vmcnt(0)" ::: "memory"); __syncthreads();
    if (C.tid == 0) { __builtin_amdgcn_fence(__ATOMIC_RELEASE, "agent"); asm volatile("s_waitcnt vmcnt(0)" ::: "memory"); (void)__hip_atomic_fetch_add(flag, 1u, __ATOMIC_RELAXED, __HIP_MEMORY_SCOPE_AGENT); }
}
DI void sample_final(const Ctx& C0, const ull* ssq_in) {
    Ctx C = C0; C.tid = (int)threadIdx.x; C.lane = C.tid & 63; C.lds = lds_base(); asm volatile("" : "+v"(C.tid), "+v"(C.lane), "+v"(C.lds), "+s"(C.a), "+s"(C.ws), "+s"(C.out));
    int oz = 0; asm volatile("" : "+s"(oz));
    const int gw = C.vcu * NWAVES + C.wave + oz, lane = C.lane;
    if (gw >= MS) return;
    const unsigned short* SL = WSP(unsigned short, WS_O); const float* H = WSP(float, WS_H); const bf16* PP = WSP(bf16, WS_PP); const float* nf = INP(I_NFIN);
    const int rr = gw, row = MP + rr; float ss = 0.f;
    const float rs = pg8::rs_from_ssq(ssq_in, row + (int)vzero());
    f32x4 ov[8];
#pragma unroll
    for (int j = 0; j < 8; ++j) { const int col = 256 * j + 4 * lane;
        f32x4 a = {0.f, 0.f, 0.f, 0.f};
#pragma unroll
        for (int sl = 0; sl < 8; ++sl) a += ld_h4(SL + ((size_t)sl * 512 + rr) * 2048 + col);
        const f32x4 hv = *(const f32x4*)(H + (size_t)row * DM + col); const v2u pw = *(const v2u*)(PP + (size_t)row * DM + col); a = a * rs;
        f32x4 o; o[0] = hv[0] + sigm(a[0]) * pg8::bf_lo(pw.x); o[1] = hv[1] + sigm(a[1]) * pg8::bf_hi(pw.x); o[2] = hv[2] + sigm(a[2]) * pg8::bf_lo(pw.y); o[3] = hv[3] + sigm(a[3]) * pg8::bf_hi(pw.y);
        ss += (o[0] * o[0] + o[1] * o[1]) + (o[2] * o[2] + o[3] * o[3]); ov[j] = o; }
    ss = wave_sum(ss);
    const float rf = rsqrtf((float)(ull)(ss * pg8::SSQ_SCALE + 0.5f) * (1.0f / (pg8::SSQ_SCALE * 2048.0f)) + 1e-6f);
#pragma unroll
    for (int j = 0; j < 8; ++j) { const f32x4 w = *(const f32x4*)(nf + 256 * j + 4 * lane); __builtin_nontemporal_store(ov[j] * rf * w, (f32x4*)(C.out + (size_t)row * DM + 256 * j + 4 * lane)); }
}

#ifndef DUP_PHASE
#define DUP_PHASE -1
#endif
#ifndef EN_P0
#define EN_P0 1
#endif
#ifndef EN_PREP
#define EN_PREP 31
#endif
#ifndef EN_WALK
#define EN_WALK 255
#endif
#ifndef EN_POST
#define EN_POST 1
#endif
#ifndef EN_GLU
#define EN_GLU 1
#endif
#ifndef EN_PPG
#define EN_PPG 1
#endif
#ifndef EN_GEMM
#define EN_GEMM 63
#endif
__global__ void __launch_bounds__(NWAVES * 64, 2) hybrid_fwd(Args args) {
    extern __shared__ __attribute__((aligned(16))) unsigned char lds[];
    Ctx C;
    C.lds = (LAS unsigned char*)lds; C.ws = args.ws; C.out = args.out; C.a = (const CAS Args*)__builtin_amdgcn_kernarg_segment_ptr();
    C.tid = threadIdx.x; C.lane = C.tid & 63; C.wave = __builtin_amdgcn_readfirstlane(C.tid >> 6);
    C.G = gridDim.x; { const int bx = blockIdx.x; C.vcu = (C.G % 8 == 0) ? (bx % 8) * (C.G / 8) + bx / 8 : bx; }
    volatile LAS unsigned* MISC = (volatile LAS unsigned*)(C.lds + MISC_OFF);
    for (int u = C.tid; u < (LDS_BYTES - MISC_OFF) / 4; u += NWAVES * 64) ((LAS unsigned*)(C.lds + MISC_OFF))[u] = 0u;
    __syncthreads();
    XcdBarrier bar; bar.bar = (unsigned*)(C.ws) + CW_BAR; bar.x = 0; bar.st = nullptr;
    if (!MK_PER_PHASE) bar = xcd_barrier_post((unsigned*)(C.ws) + CW_BAR, MISC + 8);
    const int lo = args.ph_lo, hi = args.ph_hi;
#define IN(k) (lo <= (k) && (k) < hi)
#define SEAM(k) do { if (IN(k) && IN((k) + 1)) { xcd_barrier(bar); if (DUP_PHASE == 10) xcd_barrier(bar); } } while (0)
    const int bx = (int)blockIdx.x;

    if (EN_P0 && IN(0)) { p0_prologue(C); if (DUP_PHASE == 0) { xcd_barrier(bar); p0_prologue(C); } } SEAM(0);
#pragma unroll 1
    for (int l = 0; l < 2; ++l) {
        const int pb = 1 + 8 * l;
        if ((EN_GEMM & 1) && IN(pb + 0)) {
            unsigned char* wsq = C.ws; const CAS Args* ap = C.a; int bxq = bx, Gq = C.G; asm volatile("" : "+s"(wsq), "+s"(ap), "+s"(bxq), "+s"(Gq)); unsigned char* wl = wsq + WS_W + (size_t)l * WL_BYTES; ull* ssq = (ull*)(wsq + SSQ_OFF);
            if (l > 0 && bxq >= 192) sample_reduce(C, 1, 8, nullptr, ssq + (size_t)(3 * l) * M, ssq + (size_t)(3 * l - 1) * M, (bf16*)(wsq + WS_XB), 192, 64, (unsigned*)wsq + CW_DEP + 64 * (3 * l - 1));
            pg8::Gemm g{(const pg8::bf16_t*)(wsq + WS_XB), (const pg8::bf16_t*)(wl + WO_IN), M, NINP, DM, DM}; pg8::StaticOrder S; S.init(M, NINP, Gq, bxq);
            if (l > 0) { S.dflag = (const unsigned*)wsq + CW_DEP + 64 * (3 * l - 1); S.dtarget = 64; S.dpm = 32; }
            pg8::EpiProj E{(pg8::bf16_t*)(wsq + WS_P), (float*)(wsq + WS_PS), ssq + (size_t)(3 * l) * M};
            int nrep = (DUP_PHASE == 8) ? 2 : 1; asm volatile("" : "+s"(nrep));
            for (int rep = 0; rep < nrep; ++rep) pg8::gemm_phase<pg8::EpiProj, pg8::StaticOrder, true, true>(C.lds, g, S, E);
            if (bxq >= 82) {
                pg8::Gemm g2{(const pg8::bf16_t*)(wsq + WS_PEMB + (size_t)l * M * PLE * 2), (const pg8::bf16_t*)(wl + WO_PP), M, DM, PLE, PLE}; pg8::StaticOrder S2; S2.init(M, DM, Gq - 82, bxq - 82);
                pg8::EpiPlain E2{(pg8::bf16_t*)(wsq + WS_PP), DM};
                int nrep2 = (DUP_PHASE == 19) ? 5 : 1; asm volatile("" : "+s"(nrep2));
                for (int rep = 0; rep < nrep2; ++rep) pg8::gemm_phase<pg8::EpiPlain, pg8::StaticOrder, true, true>(C.lds, g2, S2, E2);
            }
        }
        SEAM(pb + 0);
        if (EN_PREP && IN(pb + 1)) { prep_phase(C, l); if (DUP_PHASE == 1) { xcd_barrier(bar); prep_phase(C, l); } }
        SEAM(pb + 1);
        if (EN_WALK && IN(pb + 2)) {
            int nrep = (DUP_PHASE == 2 || DUP_PHASE == 4 || DUP_PHASE == 5 || DUP_PHASE == 20 || DUP_PHASE == 21) ? 2 : 1; asm volatile("" : "+s"(nrep));
            for (int rep = 0; rep < nrep; ++rep) { if (rep) xcd_barrier(bar); walk_phase(C, l, rep == 0 ? 3 : (DUP_PHASE == 4 ? 2 : DUP_PHASE == 5 ? 1 : DUP_PHASE == 20 ? 5 : DUP_PHASE == 21 ? 9 : 3)); }
        }
        SEAM(pb + 2);
        if ((EN_GEMM & 2) && IN(pb + 3)) {
            unsigned char* wsq = C.ws; const CAS Args* ap = C.a; int bxq = bx, Gq = C.G; asm volatile("" : "+s"(wsq), "+s"(ap), "+s"(bxq), "+s"(Gq)); unsigned char* wl = wsq + WS_W + (size_t)l * WL_BYTES; ull* ssq = (ull*)(wsq + SSQ_OFF);
            if (EN_GLU) { pg8::Gemm g{(const pg8::bf16_t*)(wsq + WS_YS5), (const pg8::bf16_t*)(wl + WO_GLU), M, 512, 512, 512}; pg8::StaticOrder S; S.init(M, 512, Gq, bxq);
              pg8::EpiGlu E{(const pg8::bf16_t*)(wsq + WS_YS5), (pg8::bf16_t*)(wsq + WS_MIX), ap->in[I_S5BG] + (size_t)l * 512};
              int nrep = (DUP_PHASE == 17) ? 2 : 1; asm volatile("" : "+s"(nrep));
              for (int rep = 0; rep < nrep; ++rep) pg8::gemm_phase<pg8::EpiGlu, pg8::StaticOrder, true, true>(C.lds, g, S, E); }
            if (EN_POST) post_rows(C, l, 68);
            if (DUP_PHASE == 3) { xcd_barrier(bar); post_rows(C, l, 68); }
        }
        SEAM(pb + 3);
#pragma unroll 1
        for (int t = 0; t < 3; ++t) {
            const int pm_ = pb + (t == 0 ? 4 : t == 1 ? 6 : 7);
            if (t == 1) {
                if ((EN_GEMM & 8) && IN(pb + 5)) {
                    unsigned char* wsq = C.ws; const CAS Args* ap = C.a; int bxq = bx, Gq = C.G; asm volatile("" : "+s"(wsq), "+s"(ap), "+s"(bxq), "+s"(Gq)); unsigned char* wl = wsq + WS_W + (size_t)l * WL_BYTES; ull* ssq = (ull*)(wsq + SSQ_OFF);
                    if (bxq >= 216) sample_reduce(C, 0, 8, l == 0 ? ap->in[I_XS] : (const float*)(wsq + WS_H) + (size_t)MP * DM, ssq + (size_t)(3 * l + 1) * M, nullptr, (bf16*)(wsq + WS_XA), 216, 40, (unsigned*)wsq + CW_DEP + 64 * (3 * l));
                    pg8::Gemm g{(const pg8::bf16_t*)(wsq + WS_XA), (const pg8::bf16_t*)(wl + WO_FI), M, 2 * FF, DM, DM}; pg8::StaticOrder S; S.init(M, 2 * FF, Gq, bxq);
                    S.dflag = (const unsigned*)wsq + CW_DEP + 64 * (3 * l); S.dtarget = 40; S.dpm = 32;
                    pg8::EpiSwiGLU E{(pg8::bf16_t*)(wsq + WS_P), ssq + (size_t)(3 * l + 1) * M};
                    int nrep = (DUP_PHASE == 9) ? 2 : 1; asm volatile("" : "+s"(nrep));
                    for (int rep = 0; rep < nrep; ++rep) pg8::gemm_phase<pg8::EpiSwiGLU, pg8::StaticOrder, true, true>(C.lds, g, S, E);
                }
                SEAM(pb + 5);
            }
            if ((EN_GEMM & 4) && IN(pm_)) {
                unsigned char* wsq = C.ws; const CAS Args* ap = C.a; int bxq = bx, Gq = C.G; asm volatile("" : "+s"(wsq), "+s"(ap), "+s"(bxq), "+s"(Gq)); unsigned char* wl = wsq + WS_W + (size_t)l * WL_BYTES; ull* ssq = (ull*)(wsq + SSQ_OFF);
                const pg8::bf16_t* Aop = (const pg8::bf16_t*)(wsq + (t == 0 ? WS_MIX : t == 1 ? WS_P : WS_XA)); const pg8::bf16_t* Bop = (const pg8::bf16_t*)(wl + (t == 0 ? WO_OUT : t == 1 ? WO_FO : WO_PG));
                const int Kfull = t == 1 ? FF : DM, NS = t == 1 ? 11 : 8;
                if (t == 2 && bxq >= 192) sample_reduce(C, 0, 11, (const float*)(wsq + WS_H) + (size_t)MP * DM, ssq + (size_t)(3 * l + 2) * M, nullptr, (bf16*)(wsq + WS_XA), 192, 64, (unsigned*)wsq + CW_DEP + 64 * (3 * l + 1));
                if (t < 2) {
                    pg8::Gemm g{Aop, Bop, MP, DM, Kfull, Kfull}; pg8::StaticOrder S; S.init(MP, DM, Gq, bxq);
                    pg8::EpiResidF E{(const pg8::bf16_t*)(wsq + (t == 0 ? WS_XB : WS_XA)), (pg8::bf16_t*)(wsq + WS_XA), ssq + (size_t)(3 * l + 1 + t) * M};
                    pg8::gemm_phase<pg8::EpiResidF, pg8::StaticOrder, false, true>(C.lds, g, S, E);
                } else {
                    pg8::Gemm g{Aop, Bop, MP, DM, Kfull, Kfull}; pg8::StaticOrder S; S.init(MP, DM, Gq, bxq);
                    pg8::EpiPleF E{(const pg8::bf16_t*)(wsq + WS_XA), (const pg8::bf16_t*)(wsq + WS_PP), (pg8::bf16_t*)(wsq + WS_XB), ssq + (size_t)(3 * l + 2) * M, ssq + (size_t)(3 * l + 3) * M};
                    pg8::gemm_phase<pg8::EpiPleF, pg8::StaticOrder, false, true>(C.lds, g, S, E);
                }
                if (DUP_PHASE == 15) { pg8::Gemm g{Aop, Bop, MP, DM, Kfull, Kfull}; pg8::StaticOrder S; S.init(MP, DM, Gq, bxq); pg8::EpiNull E{}; pg8::gemm_phase<pg8::EpiNull, pg8::StaticOrder, true, true>(C.lds, g, S, E); }
                {
                    pg8::Gemm g{Aop, Bop, M, DM, t == 1 ? 512 : 256, Kfull}; pg8::SliceOrder S; S.init(32, 2, DM, NS, Gq, bxq);
                    if (t == 2) { S.dflag = (const unsigned*)wsq + CW_DEP + 64 * (3 * l + 1); S.dtarget = 64; S.dpm = 32; }
                    pg8::EpiPartial E{(unsigned short*)(wsq + WS_O)};
                    int nrep = (DUP_PHASE == 16) ? 2 : 1; asm volatile("" : "+s"(nrep));
                    for (int rep = 0; rep < nrep; ++rep) pg8::gemm_phase<pg8::EpiPartial, pg8::SliceOrder, true, true>(C.lds, g, S, E);
                }
            }
            SEAM(pm_);
        }
    }
    if (IN(17)) { unsigned char* wsq = C.ws; asm volatile("" : "+s"(wsq)); sample_final(C, (const ull*)(wsq + SSQ_OFF) + (size_t)5 * M); int nrep = (DUP_PHASE == 18) ? 8 : 1; asm volatile("" : "+s"(nrep)); for (int rep = 0; rep < nrep; ++rep) final_rows(C); }
#undef IN
#undef SEAM
}

extern "C" void kernel_launch(void* const* d_in, const int* in_sizes, int n_in, void* d_out, int out_size, void* d_ws, size_t ws_size, hipStream_t stream) {
    static int grid = 0;
    if (grid == 0) {
        if (n_in != N_IN || (size_t)out_size != O_END || ws_size < WS_END) { fprintf(stderr, "kernel_launch: built for %d inputs, %zu outputs, >= %zu bytes of workspace; got %d, %d, %zu; nothing launched\n", (int)N_IN, (size_t)O_END, (size_t)WS_END, n_in, out_size, ws_size); grid = -1; return; }
        int dev = 0, cus = 0;
        if (hipGetDevice(&dev) != hipSuccess || hipDeviceGetAttribute(&cus, hipDeviceAttributeMultiprocessorCount, dev) != hipSuccess) { grid = -1; return; }
        if (hipFuncSetAttribute((const void*)hybrid_fwd, hipFuncAttributeMaxDynamicSharedMemorySize, LDS_BYTES) != hipSuccess) { fprintf(stderr, "kernel_launch: hipFuncSetAttribute failed\n"); grid = -1; return; }
        (void)hipGetLastError();
        if (cus != 256) { fprintf(stderr, "kernel_launch: built for 256 CUs (one 256x256 unit per workgroup in the N = 2048 GEMMs), the device has %d; nothing launched\n", cus); grid = -1; return; }
        grid = cus;
    }
    if (grid < 0) return;
    if (hipMemsetAsync((char*)d_ws, 0, CTL_ZERO_BYTES, stream) != hipSuccess) { fprintf(stderr, "kernel_launch: hipMemsetAsync failed\n"); return; }
    Args a{};
    for (int i = 0; i < N_IN; ++i) a.in[i] = (const float*)d_in[i];
    a.out = (float*)d_out; a.ws = (unsigned char*)d_ws;
#if MK_PER_PHASE
    for (int p = 0; p < N_PHASES; ++p) { a.ph_lo = p; a.ph_hi = p + 1; hipLaunchKernelGGL(hybrid_fwd, dim3(grid), dim3(NWAVES * 64), LDS_BYTES, stream, a); }
#else
    a.ph_lo = 0; a.ph_hi = N_PHASES;
    hipLaunchKernelGGL(hybrid_fwd, dim3(grid), dim3(NWAVES * 64), LDS_BYTES, stream, a);
#endif
    const hipError_t le = hipPeekAtLastError();
    if (le != hipSuccess) fprintf(stderr, "kernel_launch: launch failed: %s\n", hipGetErrorName(le));
}
```

```cpp
#include <hip/hip_runtime.h>
#include <cstdio>
#include <cstdint>
namespace pg8 {
#define PG8_LAS __attribute__((address_space(3)))
typedef unsigned short bf16_t;
typedef short bf16x8 __attribute__((ext_vector_type(8)));
typedef float f32x4 __attribute__((ext_vector_type(4)));
typedef unsigned u32x4 __attribute__((ext_vector_type(4)));
constexpr int BM = 256, BK = 64, HALF = 128, HTB = HALF * BK * 2  , STAGE_BYTES = 8 * HTB, NXCD = 8, WGM = 8;

__host__ __device__ __forceinline__ int lds_byte(int r, int c) { const int st = (r >> 4) * 2 + (c >> 5), rr = r & 15, cc = c & 31, ob = rr * 64 + cc * 2; return st * 1024 + (ob ^ (((ob >> 9) & 1) << 5)); }
__host__ __device__ __forceinline__ void stage_rc(int b, int& R, int& C) { const int st = b / 1024, sb = b % 1024, swz = sb ^ (((sb >> 9) & 1) << 5); R = (st >> 1) * 16 + swz / 64; C = (st & 1) * 32 + (swz % 64) / 2; }
__host__ __device__ __forceinline__ int perm32(int rho) { const int n = rho >> 4, i = rho & 15; return 8 * (i >> 2) + 4 * n + (i & 3); }

struct Unit { int pm, pn, ks; };
struct Gemm { const bf16_t* A; const bf16_t* Bt; int M, N, K, ldk; };

__device__ __forceinline__ void dep_wait(const unsigned* flag, unsigned target) {
    unsigned sp = 0;
    while (__hip_atomic_load(flag, __ATOMIC_RELAXED, __HIP_MEMORY_SCOPE_AGENT) < target) { __builtin_amdgcn_s_sleep(2); if (++sp > (1u << 21)) break; }
    __builtin_amdgcn_fence(__ATOMIC_ACQUIRE, "agent");
}
struct StaticOrder {
    int nM, nN, nwg, G, c; const unsigned* dflag = nullptr; unsigned dtarget = 0; int dpm = 1 << 30;
    __host__ __device__ void init(int M, int N, int G_, int c_) { nM = M / BM; nN = N / BM; nwg = nM * nN; G = G_; c = c_; }
    __host__ __device__ bool next(int i, Unit& u) const {
        const long L = (long)i * G + c; if (L >= nwg) return false;
        int wgid = (int)L; { const int q = nwg / NXCD, r = nwg % NXCD, xcd = wgid % NXCD, off = wgid / NXCD; wgid = (xcd < r ? xcd * (q + 1) : r * (q + 1) + (xcd - r) * q) + off; }
        const int nig = WGM * nN, gid = wgid / nig, fm = gid * WGM, gsz = (nM - fm) < WGM ? (nM - fm) : WGM;
        u.pm = fm + ((wgid % nig) % gsz); u.pn = (wgid % nig) / gsz; u.ks = 0; return true;
    }
    __device__ __forceinline__ void a_ready(const Unit& u) const { if (u.pm >= dpm) dep_wait(dflag, dtarget); }
    __device__ __forceinline__ void done(const Unit&) const {}
};
struct SliceOrder {
    int pm0, nP, nN, NS, G, c; const unsigned* dflag = nullptr; unsigned dtarget = 0; int dpm = 1 << 30;
    __host__ __device__ void init(int pm0_, int nP_, int N, int NS_, int G_, int c_) { pm0 = pm0_; nP = nP_; nN = N / BM; NS = NS_; G = G_; c = c_; }
    __host__ __device__ bool next(int i, Unit& u) const {
        const long L = (long)i * G + c; if (L >= (long)nP * nN * NS) return false;
        const int per = nN * NS, l2 = (int)L; u.pm = pm0 + l2 / per; u.pn = (l2 % per) / NS; u.ks = l2 % NS; return true;
    }
    __device__ __forceinline__ void a_ready(const Unit& u) const { if (u.pm >= dpm) dep_wait(dflag, dtarget); }
    __device__ __forceinline__ void done(const Unit&) const {}
};

typedef float f32x2v __attribute__((ext_vector_type(2)));
typedef __bf16 bf16x2v __attribute__((ext_vector_type(2)));
typedef unsigned u32x2 __attribute__((ext_vector_type(2)));
typedef unsigned long long ull_t;
__device__ __forceinline__ unsigned cvt_pk_bf16(float lo, float hi) { f32x2v v = {lo, hi}; bf16x2v b = __builtin_convertvector(v, bf16x2v); return __builtin_bit_cast(unsigned, b); }
__device__ __forceinline__ float bf_lo(unsigned w) { return __uint_as_float(w << 16); }
__device__ __forceinline__ float bf_hi(unsigned w) { return __uint_as_float(w & 0xffff0000u); }
constexpr float SSQ_SCALE = 1048576.0f;
__device__ __forceinline__ float rs_from_ssq(const ull_t* ssq, int row) { return rsqrtf((float)ssq[row] * (1.0f / (SSQ_SCALE * 2048.0f)) + 1e-6f); }
__device__ __forceinline__ float sigm(float x) { return __builtin_amdgcn_rcpf(1.0f + __builtin_amdgcn_exp2f(-1.4426950408889634f * x)); }
__device__ __forceinline__ float xor32_sum(float v) { const unsigned u = __builtin_bit_cast(unsigned, v); const auto r = __builtin_amdgcn_permlane32_swap(u, u, false, false); return __builtin_bit_cast(float, (unsigned)r[0]) + __builtin_bit_cast(float, (unsigned)r[1]); }
__device__ __forceinline__ float xor16_sum(float v) { const unsigned u = __builtin_bit_cast(unsigned, v); const auto r = __builtin_amdgcn_permlane16_swap(u, u, false, false); return __builtin_bit_cast(float, (unsigned)r[0]) + __builtin_bit_cast(float, (unsigned)r[1]); }

struct EpiProj {
    static constexpr bool PERM = true, AFTER_DRAIN = false;
    bf16_t* P; float* PS; const ull_t* ssq;
    __device__ __forceinline__ void operator()(const f32x4 (&acc)[2][2][4][2], const Unit& u, int wr, int wc, int fr, int fq) const {
        const int row0 = u.pm * BM + wr * 64 + fr;
#pragma unroll
        for (int ai = 0; ai < 2; ++ai)
#pragma unroll
            for (int m = 0; m < 4; ++m) {
                const int row = row0 + ai * HALF + m * 16; const float rs = rs_from_ssq(ssq, row);
                if (u.pn < 24) {
                    bf16_t* rowp = P + (size_t)row * 6144 + u.pn * BM + wc * 32 + 8 * fq;
#pragma unroll
                    for (int bj = 0; bj < 2; ++bj) { const f32x4 v0 = acc[ai][bj][m][0] * rs, v1 = acc[ai][bj][m][1] * rs;
                        u32x4 w; w.x = cvt_pk_bf16(v0[0], v0[1]); w.y = cvt_pk_bf16(v0[2], v0[3]); w.z = cvt_pk_bf16(v1[0], v1[1]); w.w = cvt_pk_bf16(v1[2], v1[3]);
                        *(u32x4*)(rowp + bj * HALF) = w; }
                } else if (wc == 0 && fq < 2) {
                    float* pp = PS + (size_t)row * 16 + 8 * fq;
                    *(f32x4*)pp = acc[ai][0][m][0] * rs; *(f32x4*)(pp + 4) = acc[ai][0][m][1] * rs;
                }
            }
    }
};
struct EpiSwiGLU {
    static constexpr bool PERM = true, AFTER_DRAIN = false;
    bf16_t* ACT; const ull_t* ssq;
    __device__ __forceinline__ void operator()(const f32x4 (&acc)[2][2][4][2], const Unit& u, int wr, int wc, int fr, int fq) const {
        const int row0 = u.pm * BM + wr * 64 + fr;
#pragma unroll
        for (int ai = 0; ai < 2; ++ai)
#pragma unroll
            for (int m = 0; m < 4; ++m) {
                const int row = row0 + ai * HALF + m * 16; const float rs = rs_from_ssq(ssq, row);
                bf16_t* rowp = ACT + (size_t)row * 5632 + u.pn * 128 + wc * 32 + 8 * fq;
                float a[8];
#pragma unroll
                for (int n = 0; n < 2; ++n)
#pragma unroll
                    for (int j = 0; j < 4; ++j) { const float g = acc[ai][0][m][n][j] * rs, up = acc[ai][1][m][n][j] * rs; a[4 * n + j] = g * sigm(g) * up; }
                u32x4 w; w.x = cvt_pk_bf16(a[0], a[1]); w.y = cvt_pk_bf16(a[2], a[3]); w.z = cvt_pk_bf16(a[4], a[5]); w.w = cvt_pk_bf16(a[6], a[7]);
                *(u32x4*)rowp = w;
            }
    }
};
struct EpiGlu {
    static constexpr bool PERM = true, AFTER_DRAIN = false;
    const bf16_t* Y; bf16_t* MIX; const float* bglu;
    __device__ __forceinline__ void operator()(const f32x4 (&acc)[2][2][4][2], const Unit& u, int wr, int wc, int fr, int fq) const {
        const int row0 = u.pm * BM + wr * 64 + fr;
        f32x4 b0[2], b1[2];
#pragma unroll
        for (int bj = 0; bj < 2; ++bj) { const int c0 = u.pn * BM + bj * HALF + wc * 32 + 8 * fq; b0[bj] = *(const f32x4*)(bglu + c0); b1[bj] = *(const f32x4*)(bglu + c0 + 4); }
#pragma unroll
        for (int ai = 0; ai < 2; ++ai) {
            u32x4 yw[4][2];
#pragma unroll
            for (int m = 0; m < 4; ++m)
#pragma unroll
                for (int bj = 0; bj < 2; ++bj) yw[m][bj] = *(const u32x4*)(Y + (size_t)(row0 + ai * HALF + m * 16) * 512 + u.pn * BM + bj * HALF + wc * 32 + 8 * fq);
#pragma unroll
            for (int m = 0; m < 4; ++m) {
                const int row = row0 + ai * HALF + m * 16;
#pragma unroll
                for (int bj = 0; bj < 2; ++bj) { const int c0 = u.pn * BM + bj * HALF + wc * 32 + 8 * fq; const u32x4 y = yw[m][bj];
                    const f32x4 v0 = acc[ai][bj][m][0] + b0[bj], v1 = acc[ai][bj][m][1] + b1[bj];
                    u32x4 w; w.x = cvt_pk_bf16(bf_lo(y.x) * sigm(v0[0]), bf_hi(y.x) * sigm(v0[1])); w.y = cvt_pk_bf16(bf_lo(y.y) * sigm(v0[2]), bf_hi(y.y) * sigm(v0[3]));
                    w.z = cvt_pk_bf16(bf_lo(y.z) * sigm(v1[0]), bf_hi(y.z) * sigm(v1[1])); w.w = cvt_pk_bf16(bf_lo(y.w) * sigm(v1[2]), bf_hi(y.w) * sigm(v1[3]));
                    *(u32x4*)(MIX + (size_t)row * 2048 + c0) = w; }
            }
        }
    }
};
struct EpiPlain {
    static constexpr bool PERM = true, AFTER_DRAIN = false;
    bf16_t* O; int ldc;
    __device__ __forceinline__ void operator()(const f32x4 (&acc)[2][2][4][2], const Unit& u, int wr, int wc, int fr, int fq) const {
        const int row0 = u.pm * BM + wr * 64 + fr;
#pragma unroll
        for (int ai = 0; ai < 2; ++ai)
#pragma unroll
            for (int m = 0; m < 4; ++m) {
                bf16_t* rowp = O + (size_t)(row0 + ai * HALF + m * 16) * ldc + u.pn * BM + wc * 32 + 8 * fq;
#pragma unroll
                for (int bj = 0; bj < 2; ++bj) { const f32x4 v0 = acc[ai][bj][m][0], v1 = acc[ai][bj][m][1];
                    u32x4 w; w.x = cvt_pk_bf16(v0[0], v0[1]); w.y = cvt_pk_bf16(v0[2], v0[3]); w.z = cvt_pk_bf16(v1[0], v1[1]); w.w = cvt_pk_bf16(v1[2], v1[3]);
                    *(u32x4*)(rowp + bj * HALF) = w; }
            }
    }
};
typedef _Float16 f16x2 __attribute__((ext_vector_type(2)));
__device__ __forceinline__ unsigned cvt_pk_f16(float a, float b) { f16x2 h; h[0] = (_Float16)a; h[1] = (_Float16)b; return __builtin_bit_cast(unsigned, h); }
struct EpiPartial {
    static constexpr bool PERM = true, AFTER_DRAIN = false;
    unsigned short* SL;
    __device__ __forceinline__ void operator()(const f32x4 (&acc)[2][2][4][2], const Unit& u, int wr, int wc, int fr, int fq) const {
        const int col0 = u.pn * BM + wc * 32 + 8 * fq;
#pragma unroll
        for (int ai = 0; ai < 2; ++ai)
#pragma unroll
            for (int m = 0; m < 4; ++m) {
                const int row = (u.pm - 32) * BM + ai * HALF + wr * 64 + m * 16 + fr; unsigned short* rp = SL + ((size_t)u.ks * 512 + row) * 2048 + col0;
#pragma unroll
                for (int bj = 0; bj < 2; ++bj) { const f32x4 v0 = acc[ai][bj][m][0], v1 = acc[ai][bj][m][1];
                    u32x4 w; w.x = cvt_pk_f16(v0[0], v0[1]); w.y = cvt_pk_f16(v0[2], v0[3]); w.z = cvt_pk_f16(v1[0], v1[1]); w.w = cvt_pk_f16(v1[2], v1[3]);
                    *(u32x4*)(rp + bj * HALF) = w; }
            }
    }
};
struct EpiNull {
    static constexpr bool PERM = false, AFTER_DRAIN = false;
    __device__ __forceinline__ void operator()(const f32x4 (&acc)[2][2][4][2], const Unit&, int, int, int, int) const {
#pragma unroll
        for (int ai = 0; ai < 2; ++ai)
#pragma unroll
            for (int bj = 0; bj < 2; ++bj)
#pragma unroll
                for (int m = 0; m < 4; ++m)
#pragma unroll
                    for (int n = 0; n < 2; ++n) asm volatile("" :: "v"(acc[ai][bj][m][n]));
    }
};
__device__ __forceinline__ float wave_sum_dpp(float v) {
    v += __builtin_bit_cast(float, __builtin_amdgcn_update_dpp(0, __builtin_bit_cast(int, v), 0xB1, 0xF, 0xF, true));
    v += __builtin_bit_cast(float, __builtin_amdgcn_update_dpp(0, __builtin_bit_cast(int, v), 0x4E, 0xF, 0xF, true));
    v += __builtin_bit_cast(float, __builtin_amdgcn_update_dpp(0, __builtin_bit_cast(int, v), 0x141, 0xF, 0xF, true));
    v += __builtin_bit_cast(float, __builtin_amdgcn_update_dpp(0, __builtin_bit_cast(int, v), 0x140, 0xF, 0xF, true));
    const int iv = __builtin_bit_cast(int, v);
    return (__builtin_bit_cast(float, __builtin_amdgcn_readlane(iv, 0)) + __builtin_bit_cast(float, __builtin_amdgcn_readlane(iv, 16))) + (__builtin_bit_cast(float, __builtin_amdgcn_readlane(iv, 32)) + __builtin_bit_cast(float, __builtin_amdgcn_readlane(iv, 48)));
}
__device__ __forceinline__ void stage_half(const f32x4 (&acc)[2][2][4][2], int ai, PG8_LAS unsigned char* lds, int wr, int wc, int fr, int fq) {
#pragma unroll
    for (int m = 0; m < 4; ++m)
#pragma unroll
        for (int bj = 0; bj < 2; ++bj)
#pragma unroll
            for (int n = 0; n < 2; ++n) { const int rl = wr * 64 + m * 16 + fr, ck = bj * 32 + wc * 8 + n * 4 + fq; *(PG8_LAS f32x4*)(lds + rl * 1024 + ((ck ^ fr) << 4)) = acc[ai][bj][m][n]; }
}
struct EpiResidF {
    static constexpr bool PERM = false, AFTER_DRAIN = true;
    const bf16_t* baseb; bf16_t* XO; ull_t* ssq;
    __device__ __forceinline__ void operator()(const f32x4 (&)[2][2][4][2], const Unit&, int, int, int, int) const {}
    __device__ __forceinline__ void fused(f32x4 (&acc)[2][2][4][2], const Unit& u, int wr, int wc, int fr, int fq, PG8_LAS unsigned char* lds, int wid, int lane) const {
        const int col = u.pn * BM + 4 * lane;
        u32x2 bw[2][8];
#define RF_LOAD(q) do { _Pragma("unroll") for (int i = 0; i < 8; ++i) { const int rl = wid * 16 + ((q) & 1) * 8 + i; bw[(q) & 1][i] = *(const u32x2*)(baseb + (size_t)(u.pm * BM + ((q) >> 1) * HALF + rl) * 2048 + col); } } while (0)
        RF_LOAD(0);
#pragma unroll
        for (int q = 0; q < 4; ++q) {
            const int ai = q >> 1, hb = q & 1;
            if (hb == 0) { stage_half(acc, ai, lds, wr, wc, fr, fq); asm volatile("s_waitcnt lgkmcnt(0)" ::: "memory"); __builtin_amdgcn_s_barrier(); asm volatile("" ::: "memory"); }
            if (q < 3) RF_LOAD(q + 1);
            f32x4 av[8];
#pragma unroll
            for (int i = 0; i < 8; ++i) { const int rl = wid * 16 + hb * 8 + i; av[i] = *(const PG8_LAS f32x4*)(lds + rl * 1024 + ((lane ^ (rl & 15)) << 4)); }
#pragma unroll
            for (int i = 0; i < 8; ++i) { const int rl = wid * 16 + hb * 8 + i, row = u.pm * BM + ai * HALF + rl; const size_t off = (size_t)row * 2048 + col;
                const u32x2 b = bw[q & 1][i]; f32x4 o; o[0] = bf_lo(b.x) + av[i][0]; o[1] = bf_hi(b.x) + av[i][1]; o[2] = bf_lo(b.y) + av[i][2]; o[3] = bf_hi(b.y) + av[i][3];
                u32x2 w; w.x = cvt_pk_bf16(o[0], o[1]); w.y = cvt_pk_bf16(o[2], o[3]); *(u32x2*)(XO + off) = w;
                const float ss = wave_sum_dpp((o[0] * o[0] + o[1] * o[1]) + (o[2] * o[2] + o[3] * o[3]));
                if (lane == 0) atomicAdd(ssq + row, (ull_t)(ss * SSQ_SCALE + 0.5f)); }
            if (hb == 1) { asm volatile("s_waitcnt lgkmcnt(0)" ::: "memory"); __builtin_amdgcn_s_barrier(); asm volatile("" ::: "memory"); }
        }
#undef RF_LOAD
    }
};
struct EpiPleF {
    static constexpr bool PERM = false, AFTER_DRAIN = true;
    const bf16_t* XI; const bf16_t* PP; bf16_t* XO; const ull_t* ssq_in; ull_t* ssq_out;
    __device__ __forceinline__ void operator()(const f32x4 (&)[2][2][4][2], const Unit&, int, int, int, int) const {}
    __device__ __forceinline__ void fused(f32x4 (&acc)[2][2][4][2], const Unit& u, int wr, int wc, int fr, int fq, PG8_LAS unsigned char* lds, int wid, int lane) const {
        const int col = u.pn * BM + 4 * lane;
        u32x2 hw[2][8], pw[2][8];
#define PF_LOAD(q) do { _Pragma("unroll") for (int i = 0; i < 8; ++i) { const int rl = wid * 16 + ((q) & 1) * 8 + i; const size_t off = (size_t)(u.pm * BM + ((q) >> 1) * HALF + rl) * 2048 + col; \
            hw[(q) & 1][i] = *(const u32x2*)(XI + off); pw[(q) & 1][i] = *(const u32x2*)(PP + off); } } while (0)
        PF_LOAD(0);
        float rsl[2];
#pragma unroll
        for (int ai = 0; ai < 2; ++ai) rsl[ai] = rs_from_ssq(ssq_in, u.pm * BM + ai * HALF + wid * 16 + (lane & 15));
#pragma unroll
        for (int q = 0; q < 4; ++q) {
            const int ai = q >> 1, hb = q & 1;
            if (hb == 0) { stage_half(acc, ai, lds, wr, wc, fr, fq); asm volatile("s_waitcnt lgkmcnt(0)" ::: "memory"); __builtin_amdgcn_s_barrier(); asm volatile("" ::: "memory"); }
            if (q < 3) PF_LOAD(q + 1);
            f32x4 av[8];
#pragma unroll
            for (int i = 0; i < 8; ++i) { const int rl = wid * 16 + hb * 8 + i; av[i] = *(const PG8_LAS f32x4*)(lds + rl * 1024 + ((lane ^ (rl & 15)) << 4)); }
#pragma unroll
            for (int i = 0; i < 8; ++i) { const int rl = wid * 16 + hb * 8 + i, row = u.pm * BM + ai * HALF + rl; const size_t off = (size_t)row * 2048 + col;
                const float rs = __builtin_bit_cast(float, __builtin_amdgcn_readlane(__builtin_bit_cast(int, rsl[ai]), hb * 8 + i));
                const f32x4 a = av[i] * rs; const u32x2 h = hw[q & 1][i], p = pw[q & 1][i];
                f32x4 o; o[0] = bf_lo(h.x) + sigm(a[0]) * bf_lo(p.x); o[1] = bf_hi(h.x) + sigm(a[1]) * bf_hi(p.x); o[2] = bf_lo(h.y) + sigm(a[2]) * bf_lo(p.y); o[3] = bf_hi(h.y) + sigm(a[3]) * bf_hi(p.y);
                u32x2 w; w.x = cvt_pk_bf16(o[0], o[1]); w.y = cvt_pk_bf16(o[2], o[3]); *(u32x2*)(XO + off) = w;
                const float ss = wave_sum_dpp((o[0] * o[0] + o[1] * o[1]) + (o[2] * o[2] + o[3] * o[3]));
                if (lane == 0) atomicAdd(ssq_out + row, (ull_t)(ss * SSQ_SCALE + 0.5f)); }
            if (hb == 1) { asm volatile("s_waitcnt lgkmcnt(0)" ::: "memory"); __builtin_amdgcn_s_barrier(); asm volatile("" ::: "memory"); }
        }
#undef PF_LOAD
    }
};

template <class Epi, class Sched, bool ALIGN_EPI = false, bool SP2 = false>
__device__ __forceinline__ void gemm_phase(PG8_LAS unsigned char* lds, const Gemm g, const Sched& S, const Epi& E) {
    int tid_ = threadIdx.x; asm volatile("" : "+v"(tid_));
    const int tid = tid_, wid = __builtin_amdgcn_readfirstlane(tid >> 6), lane = tid & 63, wr = wid >> 2, wc = wid & 3, fr = lane & 15, fq = lane >> 4;
    int K_ = g.K; asm volatile("" : "+s"(K_));
    const int K = K_, nt = K / BK, LDK = g.ldk;
    const size_t kslice = (size_t)K * 2;
    unsigned voffA[2], voffB[2];
#pragma unroll
    for (int i = 0; i < 2; ++i) { int R, C; stage_rc(tid * 16 + i * 8192, R, C); const int Rb = Epi::PERM ? ((R & ~31) + perm32(R & 31)) : R;
        voffA[i] = (unsigned)(R * LDK + C) * 2u; voffB[i] = (unsigned)(Rb * LDK + C) * 2u; }
    const size_t kstep = (size_t)(BK * 2);
    const size_t hstep = (size_t)HALF * LDK * 2;
    const size_t tstep = 2 * hstep;
    const unsigned ldsw = (unsigned)wid * 1024u;
    const int aoff = lds_byte(wr * 64 + fr, fq * 8), boff = lds_byte(wc * 32 + fr, fq * 8);
#define PG8_SA(b, h) (((b) * 2 + (h)) * HTB)
#define PG8_SB(b, h) ((4 + (b) * 2 + (h)) * HTB)
#define PG8_STAGE(bufoff, gbase, voff) do { _Pragma("unroll") for (int _i = 0; _i < 2; ++_i) \
        __builtin_amdgcn_global_load_lds((const unsigned*)((const char*)(gbase) + (voff)[_i]), (PG8_LAS unsigned*)(lds + (bufoff) + ldsw + _i * 8192), 16, 0, 0); } while (0)
#define PG8_LDA(dst, b, h) do { _Pragma("unroll") for (int m = 0; m < 4; ++m) _Pragma("unroll") for (int k = 0; k < 2; ++k) dst[m][k] = *(const PG8_LAS bf16x8*)(lds + PG8_SA(b, h) + aoff + m * 2048 + k * 1024); } while (0)
#define PG8_LDB(dst, b, h) do { _Pragma("unroll") for (int n = 0; n < 2; ++n) _Pragma("unroll") for (int k = 0; k < 2; ++k) dst[n][k] = *(const PG8_LAS bf16x8*)(lds + PG8_SB(b, h) + boff + n * 2048 + k * 1024); } while (0)
#define PG8_MMA(ai, bj, At, Bt) do { __builtin_amdgcn_s_setprio(1); _Pragma("unroll") for (int m = 0; m < 4; ++m) _Pragma("unroll") for (int n = 0; n < 2; ++n) _Pragma("unroll") for (int k = 0; k < 2; ++k) \
        acc[ai][bj][m][n] = __builtin_amdgcn_mfma_f32_16x16x32_bf16(Bt[n][k], At[m][k], acc[ai][bj][m][n], 0, 0, 0); __builtin_amdgcn_s_setprio(0); } while (0)
#define PG8_WAIT_V(n) asm volatile("s_waitcnt vmcnt(" #n ")" ::: "memory")
#define PG8_WAIT_L(n) asm volatile("s_waitcnt lgkmcnt(" #n ")" ::: "memory")
#define PG8_BAR __builtin_amdgcn_s_barrier()
#define PG8_SCHED __builtin_amdgcn_sched_barrier(0)
    Unit cur, nxt; int ui = 0;
    if (!S.next(0, cur)) return;
    f32x4 acc[2][2][4][2];
#pragma unroll
    for (int a = 0; a < 2; ++a)
#pragma unroll
        for (int b = 0; b < 2; ++b)
#pragma unroll
            for (int m = 0; m < 4; ++m)
#pragma unroll
                for (int n = 0; n < 2; ++n) acc[a][b][m][n] = (f32x4){0.f, 0.f, 0.f, 0.f};
    bf16x8 At[4][2], B0[2][2], B1[2][2];
    const char* cA = (const char*)g.A + (size_t)cur.pm * tstep + (size_t)cur.ks * kslice; const char* cB = (const char*)g.Bt + (size_t)cur.pn * tstep + (size_t)cur.ks * kslice;
    S.a_ready(cur);
    if constexpr (SP2) {
        PG8_STAGE(PG8_SB(0, 0), cB, voffB); PG8_STAGE(PG8_SB(0, 1), cB + hstep, voffB); PG8_STAGE(PG8_SA(0, 0), cA, voffA); PG8_STAGE(PG8_SA(0, 1), cA + hstep, voffA);
        if (wr == 1) PG8_BAR;
        PG8_WAIT_V(2); PG8_BAR;
        PG8_STAGE(PG8_SB(1, 0), cB + kstep, voffB); PG8_STAGE(PG8_SA(1, 0), cA + kstep, voffA); PG8_STAGE(PG8_SB(1, 1), cB + hstep + kstep, voffB);
        PG8_WAIT_V(6); PG8_BAR;
    } else {
        PG8_STAGE(PG8_SB(0, 0), cB, voffB); PG8_STAGE(PG8_SA(0, 0), cA, voffA); PG8_STAGE(PG8_SB(0, 1), cB + hstep, voffB); PG8_STAGE(PG8_SA(0, 1), cA + hstep, voffA);
        if (wr == 1) PG8_BAR;
        PG8_WAIT_V(4); PG8_BAR;
        PG8_STAGE(PG8_SB(1, 0), cB + kstep, voffB); PG8_STAGE(PG8_SA(1, 0), cA + kstep, voffA); PG8_STAGE(PG8_SB(1, 1), cB + hstep + kstep, voffB);
        PG8_WAIT_V(6); PG8_BAR;
    }
    for (;;) {
        const bool has_next = S.next(ui + 1, nxt);
        const char* nA = has_next ? (const char*)g.A + (size_t)nxt.pm * tstep + (size_t)nxt.ks * kslice : cA; const char* nB = has_next ? (const char*)g.Bt + (size_t)nxt.pn * tstep + (size_t)nxt.ks * kslice : cB;
        for (int t = 0; t < nt; t += 2) {
            const bool last = (t == nt - 2);
            const char* a1 = cA + (size_t)(t + 1) * kstep;
            const char* a2 = last ? nA : cA + (size_t)(t + 2) * kstep; const char* b2 = last ? nB : cB + (size_t)(t + 2) * kstep;
            const char* a3 = a2 + kstep; const char* b3 = b2 + kstep;
            if (last && has_next) S.a_ready(nxt);
            if constexpr (SP2) {
            PG8_LDB(B0, 0, 0); PG8_LDB(B1, 0, 1); PG8_SCHED; PG8_LDA(At, 0, 0); PG8_STAGE(PG8_SA(1, 1), a1 + hstep, voffA);
            PG8_WAIT_V(8); PG8_WAIT_L(0); PG8_BAR; PG8_MMA(0, 0, At, B0); PG8_MMA(0, 1, At, B1); PG8_BAR; PG8_SCHED;
            PG8_LDA(At, 0, 1); PG8_STAGE(PG8_SB(0, 0), b2, voffB); PG8_STAGE(PG8_SB(0, 1), b2 + hstep, voffB); PG8_STAGE(PG8_SA(0, 0), a2, voffA);
            PG8_WAIT_V(8); PG8_WAIT_L(0); PG8_BAR; PG8_MMA(1, 0, At, B0); PG8_MMA(1, 1, At, B1); PG8_BAR; PG8_SCHED;
            PG8_LDB(B0, 1, 0); PG8_LDB(B1, 1, 1); PG8_SCHED; PG8_LDA(At, 1, 0); PG8_STAGE(PG8_SA(0, 1), a2 + hstep, voffA);
            PG8_WAIT_V(8); PG8_WAIT_L(0); PG8_BAR; PG8_MMA(0, 0, At, B0); PG8_MMA(0, 1, At, B1); PG8_BAR; PG8_SCHED;
            PG8_LDA(At, 1, 1); PG8_STAGE(PG8_SB(1, 0), b3, voffB); PG8_STAGE(PG8_SB(1, 1), b3 + hstep, voffB); PG8_STAGE(PG8_SA(1, 0), a3, voffA);
            PG8_WAIT_V(8); PG8_WAIT_L(0); PG8_BAR; PG8_MMA(1, 0, At, B0); PG8_MMA(1, 1, At, B1); PG8_BAR; PG8_SCHED;
            } else {
            PG8_LDB(B0, 0, 0); PG8_SCHED; PG8_LDA(At, 0, 0); PG8_STAGE(PG8_SA(1, 1), a1 + hstep, voffA);
            PG8_WAIT_L(8); PG8_BAR; PG8_WAIT_L(0); PG8_MMA(0, 0, At, B0); PG8_BAR; PG8_SCHED;
            PG8_LDB(B1, 0, 1); PG8_STAGE(PG8_SB(0, 0), b2, voffB);
            PG8_BAR; PG8_WAIT_L(0); PG8_MMA(0, 1, At, B1); PG8_BAR;
            PG8_LDA(At, 0, 1); PG8_STAGE(PG8_SA(0, 0), a2, voffA);
            PG8_BAR; PG8_WAIT_L(0); PG8_MMA(1, 0, At, B0); PG8_BAR; PG8_SCHED;
            PG8_STAGE(PG8_SB(0, 1), b2 + hstep, voffB);
            PG8_WAIT_V(6); PG8_BAR; PG8_MMA(1, 1, At, B1); PG8_BAR;
            PG8_LDB(B0, 1, 0); PG8_SCHED; PG8_LDA(At, 1, 0); PG8_STAGE(PG8_SA(0, 1), a2 + hstep, voffA);
            PG8_WAIT_L(8); PG8_BAR; PG8_WAIT_L(0); PG8_MMA(0, 0, At, B0); PG8_BAR; PG8_SCHED;
            PG8_LDB(B1, 1, 1); PG8_STAGE(PG8_SB(1, 0), b3, voffB);
            PG8_BAR; PG8_WAIT_L(0); PG8_MMA(0, 1, At, B1); PG8_BAR;
            PG8_LDA(At, 1, 1); PG8_STAGE(PG8_SA(1, 0), a3, voffA);
            PG8_BAR; PG8_WAIT_L(0); PG8_MMA(1, 0, At, B0); PG8_BAR; PG8_SCHED;
            PG8_STAGE(PG8_SB(1, 1), b3 + hstep, voffB);
            PG8_WAIT_V(6); PG8_BAR; PG8_MMA(1, 1, At, B1); PG8_BAR;
            }
        }
        if constexpr (ALIGN_EPI) { if (wr == 0) PG8_BAR; }
        if constexpr (!Epi::AFTER_DRAIN) { E(acc, cur, wr, wc, fr, fq); S.done(cur); }
        if (!has_next) break;
#pragma unroll
        for (int a = 0; a < 2; ++a)
#pragma unroll
            for (int b = 0; b < 2; ++b)
#pragma unroll
                for (int m = 0; m < 4; ++m)
#pragma unroll
                    for (int n = 0; n < 2; ++n) acc[a][b][m][n] = (f32x4){0.f, 0.f, 0.f, 0.f};
        cur = nxt; cA = nA; cB = nB; ++ui;
        if constexpr (ALIGN_EPI) { if (wr == 1) PG8_BAR; }
    }
    PG8_WAIT_V(0);
    if constexpr (!ALIGN_EPI) { if (wr == 0) PG8_BAR; }
    PG8_BAR;
    if constexpr (Epi::AFTER_DRAIN) { E.fused(acc, cur, wr, wc, fr, fq, lds, wid, lane); S.done(cur); }
#undef PG8_SA
#undef PG8_SB
#undef PG8_STAGE
#undef PG8_LDA
#undef PG8_LDB
#undef PG8_MMA
#undef PG8_WAIT_V
#undef PG8_WAIT_L
#undef PG8_BAR
#undef PG8_SCHED
}
}

constexpr int NWAVES = 8;
constexpr int DM = 2048, SEQ = 2048, NB = 4, MP = NB * SEQ, SB = 128, ST = 4, MS = SB * ST, M = MP + MS;
constexpr int NINP = 6400, LDP = 6144, FF = 5632, PLE = 256, NIN_SRC = 6160;
constexpr int C_S5U = 0, C_GQ = 512, C_GK = 1024, C_GV = 1536, C_GZ = 2048, C_CZ = 2560, C_XBC = 3072, C_RQ = 4096, C_RK = 4608, C_RV = 5120, C_RG = 5632;
constexpr int NCH = SEQ / 64;
constexpr float EPS = 1e-6f;
#ifndef MK_PER_PHASE
#define MK_PER_PHASE 0
#endif
constexpr int N_PHASES = 18;

enum { I_XP = 0, I_XS, I_PP, I_PS, I_S5RE, I_S5IM, I_SGDN, I_SGDNC, I_SSSD, I_SSSDC, I_SRET, I_NMIX, I_WIN, I_S5ARE, I_S5AIM, I_S5BRE, I_S5BIM, I_S5CRE, I_S5CIM, I_S5D, I_S5LS,
       I_S5WG, I_S5BG, I_GCW, I_GALOG, I_GDTB, I_GNW, I_SCW, I_SCB, I_SDTB, I_SALOG, I_SD, I_SNW, I_RLW, I_RLB, I_WOUT, I_NFFN, I_WFI, I_WFO, I_NPLE, I_WPG, I_WPP, I_NFIN, N_IN };
constexpr size_t O_YP = 0, O_YS = O_YP + (size_t)MP * DM, O_PS5RE = O_YS + (size_t)MS * DM, O_PS5IM = O_PS5RE + 2 * 4 * 32 * 64, O_PGDN = O_PS5IM + 2 * 4 * 32 * 64,
    O_PGDNC = O_PGDN + 2 * 4 * 4 * 128 * 128, O_PSSD = O_PGDNC + 2 * 4 * 3 * 1536, O_PSSDC = O_PSSD + 2 * 4 * 8 * 128 * 64, O_PRET = O_PSSDC + 2 * 4 * 3 * 1024,
    O_SS5RE = O_PRET + 2 * 4 * 4 * 128 * 128, O_SS5IM = O_SS5RE + 2 * 128 * 32 * 64, O_SGDN = O_SS5IM + 2 * 128 * 32 * 64, O_SGDNC = O_SGDN + (size_t)2 * 128 * 4 * 128 * 128,
    O_SSSD = O_SGDNC + 2 * 128 * 3 * 1536, O_SSSDC = O_SSSD + (size_t)2 * 128 * 8 * 128 * 64, O_SRET = O_SSSDC + 2 * 128 * 3 * 1024, O_END = O_SRET + (size_t)2 * 128 * 4 * 128 * 128;

constexpr size_t al256(size_t x) { return (x + 255) & ~(size_t)255; }
constexpr size_t CTL_ZERO_BYTES = 1u << 20;
constexpr int CW_DEP = 8192;
constexpr int CW_BAR = 4096;
constexpr size_t SSQ_OFF = 65536;
constexpr size_t SZ_WIN = (size_t)NINP * DM * 2, SZ_WOUT = (size_t)DM * DM * 2, SZ_WFI = (size_t)2 * FF * DM * 2, SZ_WFO = (size_t)DM * FF * 2, SZ_WPG = (size_t)DM * DM * 2,
                 SZ_WPP = (size_t)DM * PLE * 2, SZ_WGLU = (size_t)512 * 512 * 2;
constexpr size_t WO_IN = 0, WO_OUT = WO_IN + SZ_WIN, WO_FI = WO_OUT + SZ_WOUT, WO_FO = WO_FI + SZ_WFI, WO_PG = WO_FO + SZ_WFO, WO_PP = WO_PG + SZ_WPG, WO_GLU = WO_PP + SZ_WPP, WL_BYTES = WO_GLU + SZ_WGLU;
constexpr size_t WS_W = CTL_ZERO_BYTES;
constexpr size_t WS_H = WS_W + 2 * WL_BYTES;
constexpr size_t WS_XA = WS_H + (size_t)M * DM * 4;
constexpr size_t WS_XB = WS_XA + (size_t)M * DM * 2;
constexpr size_t WS_P = WS_XB + (size_t)M * DM * 2;
constexpr size_t WS_PS = WS_P + (size_t)M * LDP * 2;
constexpr size_t WS_MIX = WS_PS + (size_t)M * 16 * 4;
constexpr size_t WS_PP = WS_MIX + (size_t)M * DM * 2;
constexpr size_t WS_PEMB = WS_PP + (size_t)M * DM * 2;
constexpr size_t WS_XS = WS_PEMB + (size_t)2 * M * PLE * 2;
constexpr size_t WS_YS5 = WS_XS + (size_t)M * 512 * 2;
constexpr size_t WS_LEND = WS_YS5 + (size_t)M * 512 * 2;
constexpr size_t WS_S5T = WS_LEND + (size_t)4 * 32 * 32 * 64 * 2 * 4;
constexpr size_t S5T_LAYER = (size_t)32 * 64 * 34 * 4;
constexpr size_t WS_ROT = WS_S5T + 2 * S5T_LAYER;
constexpr size_t WS_GW = al256(WS_ROT + (size_t)2052 * 64 * 2 * 4);
constexpr size_t WS_GQ = WS_GW + (size_t)512 * 16384, WS_GSC = WS_GQ + (size_t)512 * 16384, WS_GKT = WS_GSC + (size_t)512 * 8192, WS_GU = WS_GKT + (size_t)512 * 16384, WS_GG = WS_GU + (size_t)512 * 32768;
constexpr size_t WS_RQ = WS_GG + (size_t)512 * 256;
constexpr size_t WS_RK = WS_RQ + (size_t)512 * 16384, WS_RKT = WS_RK + (size_t)512 * 16384, WS_RVT = WS_RKT + (size_t)512 * 16384, WS_RVD = WS_RVT + (size_t)512 * 16384, WS_RG = WS_RVD + (size_t)512 * 16384, WS_RDT = WS_RG + (size_t)512 * 256;
constexpr size_t WS_SQ = WS_RDT + (size_t)512 * 256;
constexpr size_t WS_SK = WS_SQ + (size_t)256 * 16384, WS_SKT = WS_SK + (size_t)256 * 16384, WS_SVT = WS_SKT + (size_t)256 * 16384, WS_SVD = WS_SVT + (size_t)1024 * 8192, WS_SG = WS_SVD + (size_t)1024 * 8192, WS_SDT = WS_SG + (size_t)1024 * 256;
constexpr size_t WS_O = WS_SDT + (size_t)1024 * 256;
constexpr size_t WS_END = WS_O + (size_t)M * 1536 * 4;
static_assert(WS_END < (size_t)719 * 1024 * 1024, "workspace budget");

constexpr int LDS_BYTES = 147456;
constexpr int MISC_OFF = LDS_BYTES - 512;
constexpr int WAVE_LDS = 17408;

#define GAS __attribute__((address_space(1)))
#define LAS __attribute__((address_space(3)))
#define DI __device__ __forceinline__
typedef unsigned short bf16;
typedef unsigned v4u __attribute__((ext_vector_type(4)));
typedef unsigned v2u __attribute__((ext_vector_type(2)));
typedef float f32x4 __attribute__((ext_vector_type(4)));
typedef float f32x2 __attribute__((ext_vector_type(2)));
typedef float f32x16 __attribute__((ext_vector_type(16)));
typedef short bf16x8 __attribute__((ext_vector_type(8)));
typedef short s16x4 __attribute__((ext_vector_type(4)));
typedef GAS unsigned gu32;
typedef unsigned long long ull;
#define RLX_AGENT __ATOMIC_RELAXED, __HIP_MEMORY_SCOPE_AGENT
#define LDS_WAIT() asm volatile("s_waitcnt lgkmcnt(0)" ::: "memory")
#define VM_WAIT() asm volatile("s_waitcnt vmcnt(0)" ::: "memory")
#define MFMA32(a, b, c) __builtin_amdgcn_mfma_f32_32x32x16_bf16((a), (b), (c), 0, 0, 0)
DI unsigned f2bf(float f) { unsigned u = __builtin_bit_cast(unsigned, f); return (u + 0x7fffu + ((u >> 16) & 1u)) >> 16; }
DI unsigned pk2(float lo, float hi) { return pg8::cvt_pk_bf16(lo, hi); }
DI float bf2f(bf16 x) { return __uint_as_float((unsigned)x << 16); }
DI float sigm(float x) { return pg8::sigm(x); }
DI float siluf(float x) { return x * sigm(x); }
DI float softplusf(float x) { return x > 20.f ? x : log1pf(__expf(x)); }
DI float geluf(float x) { const float z = 0.7978845608028654f * (x + 0.044715f * x * x * x); const float e = __builtin_amdgcn_exp2f(2.8853900817779268f * z); const float th = 1.f - 2.f * __builtin_amdgcn_rcpf(1.f + e); return 0.5f * x * (1.f + th); }
template <int CTRL> DI float dpp_f(float v) { return __builtin_bit_cast(float, __builtin_amdgcn_update_dpp(0, __builtin_bit_cast(int, v), CTRL, 0xF, 0xF, true)); }
DI float wave_sum(float v) {
    v += dpp_f<0xB1>(v);
    v += dpp_f<0x4E>(v);
    v += dpp_f<0x141>(v);
    v += dpp_f<0x140>(v);
    const int iv = __builtin_bit_cast(int, v);
    const float s0 = __builtin_bit_cast(float, __builtin_amdgcn_readlane(iv, 0)), s1 = __builtin_bit_cast(float, __builtin_amdgcn_readlane(iv, 16));
    const float s2 = __builtin_bit_cast(float, __builtin_amdgcn_readlane(iv, 32)), s3 = __builtin_bit_cast(float, __builtin_amdgcn_readlane(iv, 48));
    return (s0 + s1) + (s2 + s3);
}
DI int crow(int reg, int h) { return (reg & 3) + 8 * (reg >> 2) + 4 * h; }
template <int S> DI bf16x8 pack_step(const f32x16& x) {
    v4u p; p.x = pk2(x[8 * S], x[8 * S + 1]); p.y = pk2(x[8 * S + 2], x[8 * S + 3]); p.z = pk2(x[8 * S + 4], x[8 * S + 5]); p.w = pk2(x[8 * S + 6], x[8 * S + 7]);
    return __builtin_bit_cast(bf16x8, p);
}
DI bf16x8 ldf_nat(const bf16* p, int h) { return *(const bf16x8*)(p + 8 * h); }
DI bf16x8 ldf_perm(const bf16* p, int h) { const s16x4 lo = *(const s16x4*)(p + 4 * h), hi = *(const s16x4*)(p + 8 + 4 * h); return __builtin_shufflevector(lo, hi, 0, 1, 2, 3, 4, 5, 6, 7); }
DI unsigned vzero() { unsigned z = 0u; asm volatile("" : "+v"(z)); return z; }
DI f32x16 zero16() { f32x16 z;
#pragma unroll
    for (int i = 0; i < 16; ++i) z[i] = 0.f; return z; }

#define XB_TMO      128
#define XB_XCNT(j)  (256  + 64 * (j))
#define XB_XSUB(j)  (1280 + 64 * (j))
#define XB_XGEN(j)  (2304 + 64 * (j))
#define XB_TOP      3328
#define XB_TOPGEN   3392
#define XCD_BAR_WORDS 3456
#define XB_SPIN_CAP (1u << 18)

__device__ __forceinline__ unsigned xb_ld(unsigned* p)              { return __hip_atomic_load(p, __ATOMIC_RELAXED, __HIP_MEMORY_SCOPE_AGENT); }
__device__ __forceinline__ unsigned xb_add(unsigned* p, unsigned v) { return __hip_atomic_fetch_add(p, v, __ATOMIC_RELAXED, __HIP_MEMORY_SCOPE_AGENT); }
__device__ __forceinline__ unsigned xb_xcc_id() { return (unsigned)__builtin_amdgcn_s_getreg((3 << 11) | 20) & 0xFu; }
#define XB_SPIN(cond, bar) do { unsigned _sp = 0; while (cond) { __builtin_amdgcn_s_sleep(1); \
    if ((++_sp & 255u) == 0u) { if (xb_ld(&(bar)[XB_TMO])) break; if (_sp > XB_SPIN_CAP) { atomicAdd(&(bar)[XB_TMO], 1u); break; } } } } while (0)

struct XcdBarrier {
    unsigned* bar; unsigned x;
    volatile LAS unsigned* st;
};

__device__ __forceinline__ XcdBarrier xcd_barrier_post(unsigned* bar, volatile LAS unsigned* st) {
    XcdBarrier b; b.bar = bar; b.x = xb_xcc_id(); b.st = st;
    if (threadIdx.x == 0) (void)xb_add(&bar[XB_XCNT(b.x)], 1u);
    return b;
}
__device__ __forceinline__ void xcd_barrier_complete(unsigned* bar, unsigned x, unsigned& nloc, unsigned& nx) {
    const unsigned G = gridDim.x * gridDim.y * gridDim.z;
    unsigned sum, cnt, mine, sp = 0u;
    for (;;) {
        sum = 0u; cnt = 0u; mine = 0u;
#pragma unroll
        for (unsigned j = 0; j < 16; ++j) { const unsigned c = xb_ld(&bar[XB_XCNT(j)]); sum += c; cnt += (c > 0u) ? 1u : 0u; mine = (j == x) ? c : mine; }
        if (sum == G) break;
        __builtin_amdgcn_s_sleep(1);
        if ((++sp & 255u) == 0u) { if (xb_ld(&bar[XB_TMO])) break; if (sp > XB_SPIN_CAP) { atomicAdd(&bar[XB_TMO], 1u); break; } }
    }
    nloc = mine > 0u ? mine : 1u; nx = cnt > 0u ? cnt : 1u;
}

__device__ __forceinline__ void xcd_barrier(const XcdBarrier& b) {
    asm volatile("s_waitcnt vmcnt(0)" ::: "memory");
    __syncthreads();
    if (threadIdx.x == 0) {
        unsigned* bar = b.bar;
        __builtin_amdgcn_s_waitcnt(0);
        unsigned nloc = b.st[0], nx = b.st[1];
        if (nloc == 0u) { xcd_barrier_complete(bar, b.x, nloc, nx); b.st[0] = nloc; b.st[1] = nx; }
        const unsigned old = xb_add(&bar[XB_XSUB(b.x)], 1u);
        const unsigned gen = old / nloc;
        if (old + 1u == (gen + 1u) * nloc) {
            __builtin_amdgcn_fence(__ATOMIC_RELEASE, "agent");
            asm volatile("s_waitcnt vmcnt(0)" ::: "memory");
            const unsigned og = xb_add(&bar[XB_TOP], 1u);
            const unsigned tg = og / nx;
            if (og + 1u == (tg + 1u) * nx) xb_add(&bar[XB_TOPGEN], 1u);
            else XB_SPIN(xb_ld(&bar[XB_TOPGEN]) == tg, bar);
            __builtin_amdgcn_fence(__ATOMIC_ACQUIRE, "agent");
            xb_add(&bar[XB_XGEN(b.x)], 1u);
            asm volatile("s_waitcnt vmcnt(0)" ::: "memory");
        } else {
            XB_SPIN(xb_ld(&bar[XB_XGEN(b.x)]) == gen, bar);
            __builtin_amdgcn_fence(__ATOMIC_ACQUIRE, "agent");
            asm volatile("s_waitcnt vmcnt(0)" ::: "memory");
        }
    }
    __syncthreads();
}
#ifndef DUP_PHASE
#define DUP_PHASE -1
#endif
#ifndef EN_PREP
#define EN_PREP 31
#endif

struct Args { const float* in[N_IN]; float* out; unsigned char* ws; int ph_lo, ph_hi; };
#define CAS __attribute__((address_space(4)))
struct Ctx {
    LAS unsigned char* lds; unsigned char* ws; float* out; const CAS Args* a;
    int tid, lane, wave, vcu, G;
};
DI LAS unsigned char* lds_base() { extern __shared__ __attribute__((aligned(16))) unsigned char lds_dyn_[]; return (LAS unsigned char*)lds_dyn_; }
#define WSP(T, off) ((T*)(C.ws + (off)))
#define INP(i) (C.a->in[i])

template <int MAP> DI int col_map(int n) {
    if (MAP == 0) return n;
    if (MAP == 1) {
        if (n < 2560) return n; if (n < 4096) return n + 8; if (n < 6144) return n + 16; if (n < 6152) return 2560 + (n - 6144); if (n < 6160) return 4104 + (n - 6152); return -1;
    }
    { const int pn = n >> 8, x = n & 255; return (x >> 7) * FF + pn * 128 + (x & 127); }
}
struct TItem { const float* src; size_t pitch; bf16* dst; const float* ks; int K; int ok; };
DI TItem p0_item_setup(const Ctx& C, int it, int lane) {
    constexpr int NI_IN = (DM / 64) * (NINP / 32), NI_OUT = (DM / 64) * (DM / 32), NI_FI = (DM / 64) * (2 * FF / 32), NI_FO = (FF / 64) * (DM / 32), NI_PG = NI_OUT, NI_PP = (PLE / 64) * (DM / 32), NI_GLU = (512 / 64) * (512 / 32);
    constexpr int PER_LAYER = NI_IN + NI_OUT + NI_FI + NI_FO + NI_PG + NI_PP + NI_GLU;
    const int l = it / PER_LAYER; int r = it % PER_LAYER; unsigned char* wl = C.ws + WS_W + (size_t)l * WL_BYTES;
    const float* W; int K, Nsrc, Ndst, map = 0; bf16* WT; const float* ks = nullptr;
    if (r < NI_IN) { W = INP(I_WIN) + (size_t)l * DM * NIN_SRC; K = DM; Nsrc = NIN_SRC; Ndst = NINP; WT = (bf16*)(wl + WO_IN); map = 1; ks = INP(I_NMIX) + (size_t)l * DM; }
    else if ((r -= NI_IN) < NI_OUT) { W = INP(I_WOUT) + (size_t)l * DM * DM; K = DM; Nsrc = DM; Ndst = DM; WT = (bf16*)(wl + WO_OUT); }
    else if ((r -= NI_OUT) < NI_FI) { W = INP(I_WFI) + (size_t)l * DM * 2 * FF; K = DM; Nsrc = 2 * FF; Ndst = 2 * FF; WT = (bf16*)(wl + WO_FI); map = 2; ks = INP(I_NFFN) + (size_t)l * DM; }
    else if ((r -= NI_FI) < NI_FO) { W = INP(I_WFO) + (size_t)l * FF * DM; K = FF; Nsrc = DM; Ndst = DM; WT = (bf16*)(wl + WO_FO); }
    else if ((r -= NI_FO) < NI_PG) { W = INP(I_WPG) + (size_t)l * DM * DM; K = DM; Nsrc = DM; Ndst = DM; WT = (bf16*)(wl + WO_PG); ks = INP(I_NPLE) + (size_t)l * DM; }
    else if ((r -= NI_PG) < NI_PP) { W = INP(I_WPP) + (size_t)l * PLE * DM; K = PLE; Nsrc = DM; Ndst = DM; WT = (bf16*)(wl + WO_PP); }
    else { r -= NI_PP; W = INP(I_S5WG) + (size_t)l * 512 * 512; K = 512; Nsrc = 512; Ndst = 512; WT = (bf16*)(wl + WO_GLU); }
    const int nblk = Ndst / 32, kb = r / nblk, nb = r % nblk, k0 = 64 * kb, n0 = 32 * nb, n = n0 + (lane & 31);
    const int sc = map == 1 ? col_map<1>(n) : map == 2 ? col_map<2>(n) : n;
    TItem t; t.src = W + (size_t)(k0 + (lane >> 5)) * Nsrc + (sc >= 0 ? sc : 0); t.pitch = (size_t)2 * Nsrc; t.ok = sc >= 0;
    t.dst = WT + (size_t)(n0 + (lane >> 3)) * K + k0 + 8 * (lane & 7); t.K = K; t.ks = ks ? ks + k0 + 8 * (lane & 7) : nullptr;
    return t;
}
DI void p0_item_load(const TItem& t, float (&v)[32]) {
#pragma unroll
    for (int i = 0; i < 32; ++i) v[i] = __builtin_nontemporal_load(t.src + (size_t)i * t.pitch);
}
DI void p0_item_finish(const TItem& t, const float (&v)[32], LAS float* scr, int lane) {
#pragma unroll
    for (int i = 0; i < 32; ++i) scr[(2 * i + (lane >> 5)) * 33 + (lane & 31)] = t.ok ? v[i] : 0.f;
    LDS_WAIT(); asm volatile("" ::: "memory");
    const int c = lane & 7;
    f32x4 k0v = {1.f, 1.f, 1.f, 1.f}, k1v = k0v; if (t.ks) { k0v = *(const f32x4*)(t.ks); k1v = *(const f32x4*)(t.ks + 4); }
#pragma unroll
    for (int j = 0; j < 4; ++j) { const int n = (lane >> 3) + 8 * j; const LAS float* s = scr + (8 * c) * 33 + n;
        v4u o; o.x = pk2(s[0 * 33] * k0v[0], s[1 * 33] * k0v[1]); o.y = pk2(s[2 * 33] * k0v[2], s[3 * 33] * k0v[3]); o.z = pk2(s[4 * 33] * k1v[0], s[5 * 33] * k1v[1]); o.w = pk2(s[6 * 33] * k1v[2], s[7 * 33] * k1v[3]);
        *(GAS v4u*)(t.dst + (size_t)(8 * j) * t.K) = o; }
    LDS_WAIT(); asm volatile("" ::: "memory");
}
DI void p0_prologue(const Ctx& C0) {
    Ctx C = C0; C.tid = (int)threadIdx.x; C.lane = C.tid & 63; C.lds = lds_base(); asm volatile("" : "+v"(C.tid), "+v"(C.lane), "+v"(C.lds), "+s"(C.a), "+s"(C.ws), "+s"(C.out));
    LAS float* scr = (LAS float*)(C.lds + C.wave * 16384);
    const int gw = C.vcu * NWAVES + C.wave, NGW = C.G * NWAVES, lane = C.lane;
    constexpr int NI_IN = (DM / 64) * (NINP / 32), NI_OUT = (DM / 64) * (DM / 32), NI_FI = (DM / 64) * (2 * FF / 32), NI_FO = (FF / 64) * (DM / 32), NI_PG = NI_OUT, NI_PP = (PLE / 64) * (DM / 32), NI_GLU = (512 / 64) * (512 / 32);
    constexpr int PER_LAYER = NI_IN + NI_OUT + NI_FI + NI_FO + NI_PG + NI_PP + NI_GLU;
    if (gw < 2 * PER_LAYER) {
        TItem cur = p0_item_setup(C, gw, lane); float v[32]; p0_item_load(cur, v);
#pragma unroll 1
        for (int it = gw; it < 2 * PER_LAYER; it += NGW) {
            const bool hn = it + NGW < 2 * PER_LAYER;
            TItem nxt = cur; float vn[32];
            if (hn) { nxt = p0_item_setup(C, it + NGW, lane); p0_item_load(nxt, vn); }
            p0_item_finish(cur, v, scr, lane);
            cur = nxt;
#pragma unroll
            for (int i = 0; i < 32; ++i) v[i] = vn[i];
        }
    }
    { bf16* XB = WSP(bf16, WS_XB); ull* ssq = WSP(ull, SSQ_OFF);
      constexpr int RPW = (M + 2047) / 2048;
      for (int m0 = gw; m0 < M; m0 += RPW * NGW) {
        f32x4 xv[RPW][8];
#pragma unroll
        for (int r = 0; r < RPW; ++r) { const int m = m0 + r * NGW, mm = m < M ? m : m0; const float* xrow = mm < MP ? INP(I_XP) + (size_t)mm * DM : INP(I_XS) + (size_t)(mm - MP) * DM;
#pragma unroll
            for (int j = 0; j < 8; ++j) xv[r][j] = *(const f32x4*)(xrow + 256 * j + 4 * lane); }
#pragma unroll
        for (int r = 0; r < RPW; ++r) { const int m = m0 + r * NGW; if (m < M) {
            float sq = 0.f;
#pragma unroll
            for (int j = 0; j < 8; ++j) { const f32x4 v = xv[r][j]; sq += (v[0] * v[0] + v[1] * v[1]) + (v[2] * v[2] + v[3] * v[3]);
                v2u o; o.x = pk2(v[0], v[1]); o.y = pk2(v[2], v[3]); *(v2u*)(XB + (size_t)m * DM + 256 * j + 4 * lane) = o; }
            sq = wave_sum(sq);
            if (lane == 0) ssq[m] = (ull)(sq * pg8::SSQ_SCALE + 0.5f); } }
      } }
    { bf16* PE = WSP(bf16, WS_PEMB);
      constexpr int RPW2 = (2 * M + 2047) / 2048;
      for (int m0 = gw; m0 < 2 * M; m0 += RPW2 * NGW) {
        f32x4 pv[RPW2];
#pragma unroll
        for (int r = 0; r < RPW2; ++r) { const int m = m0 + r * NGW, mm = m < 2 * M ? m : m0; const int l = mm / M, rr = mm % M;
            const float* prow = rr < MP ? INP(I_PP) + ((size_t)l * MP + rr) * PLE : INP(I_PS) + ((size_t)l * MS + (rr - MP)) * PLE;
            pv[r] = *(const f32x4*)(prow + 4 * lane); }
#pragma unroll
        for (int r = 0; r < RPW2; ++r) { const int m = m0 + r * NGW; if (m < 2 * M) { const f32x4 v = pv[r]; v2u o; o.x = pk2(v[0], v[1]); o.y = pk2(v[2], v[3]); *(v2u*)(PE + (size_t)m * PLE + 4 * lane) = o; } }
      } }
    for (int e = gw * 64 + lane; e < 2 * 32 * 64; e += NGW * 64) {
        const int l = e >> 11, gn = e & 2047, g = gn >> 6;
        const double are = INP(I_S5ARE)[(size_t)l * 2048 + gn], aim = INP(I_S5AIM)[(size_t)l * 2048 + gn], step = exp((double)INP(I_S5LS)[l * 32 + g]);
        const double mag = exp(are * step), ang = aim * step, lre = mag * cos(ang), lim = mag * sin(ang), den = are * are + aim * aim;
        const double cre = ((lre - 1.0) * are + lim * aim) / den, cim = (lim * are - (lre - 1.0) * aim) / den;
        float* T = WSP(float, WS_S5T + (size_t)l * S5T_LAYER);
        T[gn * 2] = (float)lre; T[gn * 2 + 1] = (float)lim;
        float* BB = T + 32 * 64 * 2 + (size_t)gn * 32; const float* bre = INP(I_S5BRE) + ((size_t)l * 2048 + gn) * 16; const float* bim = INP(I_S5BIM) + ((size_t)l * 2048 + gn) * 16;
#pragma unroll
        for (int c = 0; c < 16; ++c) { BB[c] = (float)(cre * bre[c] - cim * bim[c]); BB[16 + c] = (float)(cre * bim[c] + cim * bre[c]); }
    }
    for (int e = gw * 64 + lane; e < 2052 * 64; e += NGW * 64) {
        const int p = e >> 6, i = e & 63; const double pos = p < 2048 ? (double)p : (double)(16384 + p - 2048);
        const double inv = exp(-(double)i * (9.210340371976184 / 64.0)), ang = pos * inv;
        double rev = ang * 0.15915494309189535; rev -= floor(rev); const float a = (float)(rev * 6.283185307179586);
        float* R = WSP(float, WS_ROT) + (size_t)e * 2; R[0] = cosf(a); R[1] = sinf(a);
    }
}

template <int W> struct TileRaw { bf16 raw[64 / (512 / W) + 3]; float w0, w1, w2, w3, bb; };
template <int W, bool CONV> DI void load_tile_ld(const Ctx& C, TileRaw<W>& r, int row0, bool has_prev, int col0, const float* cw, const float* cb, int ch0, int CW) {
    const bf16* P = WSP(bf16, WS_P);
    constexpr int NG = 512 / W, TPG = 64 / NG;
    const int ch = C.tid % W, t0 = (C.tid / W) * TPG;
    const bf16* src = P + (size_t)row0 * LDP + col0 + ch;
    const bool prev = CONV && (t0 > 0 || has_prev);
#pragma unroll
    for (int t = 0; t < TPG + 3; ++t) r.raw[t] = (t >= 3 || prev) ? src[(long)(t0 + t - 3) * LDP] : (bf16)0;
    if (CONV) { r.w0 = cw[ch0 + ch]; r.w1 = cw[CW + ch0 + ch]; r.w2 = cw[2 * CW + ch0 + ch]; r.w3 = cw[3 * CW + ch0 + ch]; r.bb = cb ? cb[ch0 + ch] : 0.f; }
}
template <int W, bool CONV> DI void load_tile_fin(const Ctx& C, const TileRaw<W>& r, LAS float* T, int ldt) {
    constexpr int NG = 512 / W, TPG = 64 / NG;
    const int ch = C.tid % W, t0 = (C.tid / W) * TPG;
    if (CONV) {
#pragma unroll
        for (int t = 0; t < TPG; ++t) { const float y = r.w0 * bf2f(r.raw[t]) + r.w1 * bf2f(r.raw[t + 1]) + r.w2 * bf2f(r.raw[t + 2]) + r.w3 * bf2f(r.raw[t + 3]) + r.bb; T[(t0 + t) * ldt + ch] = siluf(y); }
    } else {
#pragma unroll
        for (int t = 0; t < TPG; ++t) T[(t0 + t) * ldt + ch] = bf2f(r.raw[t + 3]);
    }
}
template <int W, bool CONV> DI void load_tile(const Ctx& C, LAS float* T, int ldt, int row0, bool has_prev, int col0, const float* cw, const float* cb, int ch0, int CW) {
    TileRaw<W> r; load_tile_ld<W, CONV>(C, r, row0, has_prev, col0, cw, cb, ch0, CW); load_tile_fin<W, CONV>(C, r, T, ldt);
}
template <int W> DI void write_T(const Ctx& C, bf16* dst  , const LAS float* T, int ldt, const LAS float* rowscale) {
    for (int e = C.tid; e < W * 8; e += 512) { const int d = e % W, c0 = (e / W) * 8;
        float v[8];
#pragma unroll
        for (int i = 0; i < 8; ++i) v[i] = T[(c0 + i) * ldt + d] * (rowscale ? rowscale[c0 + i] : 1.f);
        v4u o; o.x = pk2(v[0], v[1]); o.y = pk2(v[2], v[3]); o.z = pk2(v[4], v[5]); o.w = pk2(v[6], v[7]);
        *(v4u*)(dst + d * 64 + c0) = o; }
}
template <int W> DI void write_R(const Ctx& C, bf16* dst  , const LAS float* T, int ldt) {
    for (int e = C.tid; e < 64 * W / 8; e += 512) { const int t = e / (W / 8), d0 = (e % (W / 8)) * 8; const LAS float* sp = T + t * ldt + d0;
        v4u o; o.x = pk2(sp[0], sp[1]); o.y = pk2(sp[2], sp[3]); o.z = pk2(sp[4], sp[5]); o.w = pk2(sp[6], sp[7]);
        *(v4u*)(dst + t * W + d0) = o; }
}
DI void conv_state_out(const Ctx& C, float* out  , int CW, int b, int col0, int chbase, int nch) {
    const bf16* P = WSP(bf16, WS_P);
    for (int e = C.tid; e < 3 * nch; e += 512) { const int j = e / nch, ch = e % nch; out[j * CW + chbase + ch] = bf2f(P[(size_t)(b * SEQ + SEQ - 3 + j) * LDP + col0 + ch]); }
}

DI void gdn_prep_item(const Ctx& C0, int l, int item) {
    Ctx C = C0; C.tid = (int)threadIdx.x; C.lane = C.tid & 63; C.lds = lds_base(); asm volatile("" : "+v"(C.tid), "+v"(C.lane), "+v"(C.lds), "+s"(C.a), "+s"(C.ws), "+s"(C.out));
    const int c = item & 31, bh = item >> 5, hh = bh & 3, b = bh >> 2, row0 = b * SEQ + 64 * c, tid = C.tid, lane = C.lane;
    LAS float* TQ = (LAS float*)(C.lds); LAS float* TK = (LAS float*)(C.lds + 33024); LAS float* TV = (LAS float*)(C.lds + 66048);
    LAS bf16* QB = (LAS bf16*)(C.lds + 99072); LAS bf16* KB = (LAS bf16*)(C.lds + 116480);
    LAS float* SBETA = (LAS float*)(C.lds + 133888); LAS float* SG = (LAS float*)(C.lds + 134144); LAS float* AT = TQ;
    const float* cw = INP(I_GCW) + (size_t)l * 4 * 1536;
    { TileRaw<128> rq, rk, rv;
      load_tile_ld<128, true>(C, rq, row0, c > 0, C_GQ + hh * 128, cw, nullptr, hh * 128, 1536); load_tile_ld<128, true>(C, rk, row0, c > 0, C_GK + hh * 128, cw, nullptr, 512 + hh * 128, 1536);
      load_tile_ld<128, true>(C, rv, row0, c > 0, C_GV + hh * 128, cw, nullptr, 1024 + hh * 128, 1536);
      load_tile_fin<128, true>(C, rq, TQ, 129); load_tile_fin<128, true>(C, rk, TK, 129); load_tile_fin<128, true>(C, rv, TV, 129); }
    if (C.wave == 0) {
        const float* ps = WSP(float, WS_PS) + (size_t)(row0 + lane) * 16;
        const float beta = sigm(ps[hh]); const float g = -__expf(INP(I_GALOG)[l * 4 + hh]) * softplusf(ps[4 + hh] + INP(I_GDTB)[l * 4 + hh]);
        float Gc = g;
#pragma unroll
        for (int o = 1; o < 64; o <<= 1) { const float v = __shfl_up(Gc, o); if (lane >= o) Gc += v; }
        SBETA[lane] = beta; SG[lane] = Gc;
    }
    __syncthreads();
    for (int rr = 0; rr < 16; ++rr) {
        const int row = C.wave * 16 + rr;
        if (row < 64) { LAS float* T = TQ + row * 129; const float x0 = T[lane], x1 = T[lane + 64]; const float sc = rsqrtf(wave_sum(x0 * x0 + x1 * x1) + EPS) * 0.08838834764831845f;
            QB[row * 136 + lane] = (bf16)f2bf(x0 * sc); QB[row * 136 + lane + 64] = (bf16)f2bf(x1 * sc); }
        else { LAS float* T = TK + (row - 64) * 129; float x0 = T[lane], x1 = T[lane + 64]; const float sc = rsqrtf(wave_sum(x0 * x0 + x1 * x1) + EPS); x0 *= sc; x1 *= sc;
            T[lane] = x0; T[lane + 64] = x1; KB[(row - 64) * 136 + lane] = (bf16)f2bf(x0); KB[(row - 64) * 136 + lane + 64] = (bf16)f2bf(x1); }
    }
    __syncthreads();
    {
        const int w = C.wave, isq = w >> 2, ti = (w >> 1) & 1, tj = w & 1, r = lane & 31, h = lane >> 5;
        if (tj <= ti) {
            f32x16 acc = zero16();
            const LAS bf16* X = isq ? QB : KB;
#pragma unroll
            for (int s = 0; s < 8; ++s) { const bf16x8 a = *(const LAS bf16x8*)(X + (32 * ti + r) * 136 + 16 * s + 8 * h); const bf16x8 bb = *(const LAS bf16x8*)(KB + (32 * tj + r) * 136 + 16 * s + 8 * h); acc = MFMA32(a, bb, acc); }
            const int j = 32 * tj + r; const float Gj = SG[j];
            bf16* SC = WSP(bf16, WS_GSC) + (size_t)item * 4096;
#pragma unroll
            for (int reg = 0; reg < 16; ++reg) { const int i = 32 * ti + crow(reg, h); const float dec = __expf(SG[i] - Gj);
                if (!isq) AT[j * 68 + i] = (i > j) ? SBETA[i] * acc[reg] * dec : 0.f;
                else SC[i * 64 + j] = (bf16)f2bf((i >= j) ? acc[reg] * dec : 0.f); }
        }
    }
    __syncthreads();
    if (tid < 256) {
        const int col = tid & 127; const bool isW = tid >= 128;
        float x[64];
#pragma unroll
        for (int i = 0; i < 64; ++i) x[i] = isW ? TK[i * 129 + col] * SBETA[i] * __expf(SG[i]) : TV[i * 129 + col] * SBETA[i];
        f32x4 acol[2][16];
#pragma unroll
        for (int q = 0; q < 16; ++q) acol[0][q] = *(const LAS f32x4*)(AT + 4 * q);
#pragma unroll
        for (int j = 0; j < 63; ++j) {
            if (j + 1 < 63) {
#pragma unroll
                for (int q = (j + 2) / 4; q < 16; ++q) acol[(j + 1) & 1][q] = *(const LAS f32x4*)(AT + (j + 1) * 68 + 4 * q);
            }
#pragma unroll
            for (int q = (j + 1) / 4; q < 16; ++q) { const f32x4 a = acol[j & 1][q];
#pragma unroll
                for (int e = 0; e < 4; ++e) if (4 * q + e > j) x[4 * q + e] -= a[e] * x[j]; }
        }
        if (isW) { bf16* Wp = WSP(bf16, WS_GW) + (size_t)item * 8192;
#pragma unroll
            for (int i = 0; i < 64; ++i) Wp[i * 128 + col] = (bf16)f2bf(x[i]); }
        else { float* Up = WSP(float, WS_GU) + (size_t)item * 8192;
#pragma unroll
            for (int i = 0; i < 64; ++i) Up[i * 128 + col] = x[i]; }
    } else {
        const int t2 = tid - 256;
        { bf16* Qp = WSP(bf16, WS_GQ) + (size_t)item * 8192; const int row = t2 >> 2, seg = t2 & 3;
#pragma unroll
          for (int q = 0; q < 4; ++q) *(v4u*)(Qp + row * 128 + seg * 32 + 8 * q) = *(const LAS v4u*)(QB + row * 136 + seg * 32 + 8 * q); }
        { bf16* KT = WSP(bf16, WS_GKT) + (size_t)item * 8192; const int cc = t2 & 63, d0 = (t2 >> 6) * 32; const float sc = __expf(SG[63] - SG[cc]);
          for (int d = d0; d < d0 + 32; ++d) KT[d * 64 + cc] = (bf16)f2bf(TK[cc * 129 + d] * sc); }
        if (t2 < 64) WSP(float, WS_GG)[(size_t)item * 64 + t2] = SG[t2];
    }
    if (c == NCH - 1) { float* o = C.out + O_PGDNC + (size_t)(l * 4 + b) * 3 * 1536;
        conv_state_out(C, o, 1536, b, C_GQ + hh * 128, hh * 128, 128); conv_state_out(C, o, 1536, b, C_GK + hh * 128, 512 + hh * 128, 128); conv_state_out(C, o, 1536, b, C_GV + hh * 128, 1024 + hh * 128, 128); }
    __syncthreads();
}

DI void ret_prep_item(const Ctx& C0, int l, int item) {
    Ctx C = C0; C.tid = (int)threadIdx.x; C.lane = C.tid & 63; C.lds = lds_base(); asm volatile("" : "+v"(C.tid), "+v"(C.lane), "+v"(C.lds), "+s"(C.a), "+s"(C.ws), "+s"(C.out));
    const int c = item & 31, bh = item >> 5, hh = bh & 3, b = bh >> 2, row0 = b * SEQ + 64 * c, tid = C.tid;
    LAS float* TQ = (LAS float*)(C.lds); LAS float* TK = (LAS float*)(C.lds + 33024); LAS float* TV = (LAS float*)(C.lds + 66048); LAS float* SDEC = (LAS float*)(C.lds + 99072);
    { TileRaw<128> rq, rk, rv;
      load_tile_ld<128, false>(C, rq, row0, false, C_RQ + hh * 128, nullptr, nullptr, 0, 0); load_tile_ld<128, false>(C, rk, row0, false, C_RK + hh * 128, nullptr, nullptr, 0, 0);
      load_tile_ld<128, false>(C, rv, row0, false, C_RV + hh * 128, nullptr, nullptr, 0, 0);
      load_tile_fin<128, false>(C, rq, TQ, 129); load_tile_fin<128, false>(C, rk, TK, 129); load_tile_fin<128, false>(C, rv, TV, 129); }
    const float lg = hh == 0 ? -3.1748698315e-02f : hh == 1 ? -1.5748356968e-02f : hh == 2 ? -7.8431774610e-03f : -3.9138993211e-03f;
    if (tid < 64) { SDEC[tid] = __expf((float)(63 - tid) * lg); WSP(float, WS_RG)[(size_t)item * 64 + tid] = (float)(tid + 1) * lg; WSP(float, WS_RDT)[(size_t)item * 64 + tid] = 1.f; }
    __syncthreads();
    { const float* ROT = WSP(float, WS_ROT);
      f32x2 csv[8];
#pragma unroll
      for (int k = 0; k < 8; ++k) { const int p = tid + 512 * k, t = p >> 6, i = p & 63; csv[k] = *(const f32x2*)(ROT + ((size_t)(64 * c + t) * 64 + i) * 2); }
#pragma unroll
      for (int k = 0; k < 8; ++k) { const int p = tid + 512 * k, t = p >> 6, i = p & 63; const f32x2 cs = csv[k];
        const float q1 = TQ[t * 129 + i], q2 = TQ[t * 129 + i + 64], k1 = TK[t * 129 + i], k2 = TK[t * 129 + i + 64];
        TQ[t * 129 + i] = q1 * cs.x - q2 * cs.y; TQ[t * 129 + i + 64] = q1 * cs.y + q2 * cs.x;
        TK[t * 129 + i] = (k1 * cs.x - k2 * cs.y) * 0.08838834764831845f; TK[t * 129 + i + 64] = (k1 * cs.y + k2 * cs.x) * 0.08838834764831845f; } }
    __syncthreads();
    write_R<128>(C, WSP(bf16, WS_RQ) + (size_t)item * 8192, TQ, 129);
    write_R<128>(C, WSP(bf16, WS_RK) + (size_t)item * 8192, TK, 129);
    write_T<128>(C, WSP(bf16, WS_RKT) + (size_t)item * 8192, TK, 129, nullptr);
    write_T<128>(C, WSP(bf16, WS_RVT) + (size_t)item * 8192, TV, 129, nullptr);
    write_T<128>(C, WSP(bf16, WS_RVD) + (size_t)item * 8192, TV, 129, SDEC);
    __syncthreads();
}

DI void ssdg_prep_item(const Ctx& C0, int l, int item) {
    Ctx C = C0; C.tid = (int)threadIdx.x; C.lane = C.tid & 63; C.lds = lds_base(); asm volatile("" : "+v"(C.tid), "+v"(C.lane), "+v"(C.lds), "+s"(C.a), "+s"(C.ws), "+s"(C.out));
    const int c = item & 31, bg = item >> 5, grp = bg & 1, b = bg >> 1, row0 = b * SEQ + 64 * c;
    LAS float* TB = (LAS float*)(C.lds); LAS float* TC = (LAS float*)(C.lds + 33024);
    const float* cw = INP(I_SCW) + (size_t)l * 4 * 1024; const float* cb = INP(I_SCB) + (size_t)l * 1024;
    { TileRaw<128> rb, rc;
      load_tile_ld<128, true>(C, rb, row0, c > 0, C_XBC + 512 + grp * 128, cw, cb, 512 + grp * 128, 1024); load_tile_ld<128, true>(C, rc, row0, c > 0, C_XBC + 768 + grp * 128, cw, cb, 768 + grp * 128, 1024);
      load_tile_fin<128, true>(C, rb, TB, 129); load_tile_fin<128, true>(C, rc, TC, 129); }
    __syncthreads();
    write_R<128>(C, WSP(bf16, WS_SQ) + (size_t)item * 8192, TC, 129);
    write_R<128>(C, WSP(bf16, WS_SK) + (size_t)item * 8192, TB, 129);
    write_T<128>(C, WSP(bf16, WS_SKT) + (size_t)item * 8192, TB, 129, nullptr);
    if (c == NCH - 1) { float* o = C.out + O_PSSDC + (size_t)(l * 4 + b) * 3 * 1024;
        conv_state_out(C, o, 1024, b, C_XBC + 512 + grp * 128, 512 + grp * 128, 128); conv_state_out(C, o, 1024, b, C_XBC + 768 + grp * 128, 768 + grp * 128, 128); }
    __syncthreads();
}

DI void ssdh_ld(const Ctx& C, int l, int item, TileRaw<64>& rx) {
    const int c = item & 31, bh = item >> 5, hh = bh & 7, b = bh >> 3, row0 = b * SEQ + 64 * c;
    load_tile_ld<64, true>(C, rx, row0, c > 0, C_XBC + hh * 64, INP(I_SCW) + (size_t)l * 4 * 1024, INP(I_SCB) + (size_t)l * 1024, hh * 64, 1024);
}
DI void ssdh_prep_item(const Ctx& C0, int l, int item, TileRaw<64>& rx, int next_item) {
    Ctx C = C0; C.tid = (int)threadIdx.x; C.lane = C.tid & 63; C.lds = lds_base(); asm volatile("" : "+v"(C.tid), "+v"(C.lane), "+v"(C.lds), "+s"(C.a), "+s"(C.ws), "+s"(C.out));
    const int c = item & 31, bh = item >> 5, hh = bh & 7, b = bh >> 3, row0 = b * SEQ + 64 * c, tid = C.tid, lane = C.lane;
    LAS float* TX = (LAS float*)(C.lds); LAS float* SSC = (LAS float*)(C.lds + 16640);
    load_tile_fin<64, true>(C, rx, TX, 65);
    if (C.wave == 0) {
        const float dt = softplusf(WSP(float, WS_PS)[(size_t)(row0 + lane) * 16 + 8 + hh] + INP(I_SDTB)[l * 8 + hh]); const float g = -__expf(INP(I_SALOG)[l * 8 + hh]) * dt;
        float Gc = g;
#pragma unroll
        for (int o = 1; o < 64; o <<= 1) { const float v = __shfl_up(Gc, o); if (lane >= o) Gc += v; }
        const float Glast = __builtin_bit_cast(float, __builtin_amdgcn_readlane(__builtin_bit_cast(int, Gc), 63));
        SSC[lane] = dt * __expf(Glast - Gc); WSP(float, WS_SG)[(size_t)item * 64 + lane] = Gc; WSP(float, WS_SDT)[(size_t)item * 64 + lane] = dt;
    }
    __syncthreads();
    if (next_item >= 0) ssdh_ld(C, l, next_item, rx);
    write_T<64>(C, WSP(bf16, WS_SVT) + (size_t)item * 4096, TX, 65, nullptr);
    write_T<64>(C, WSP(bf16, WS_SVD) + (size_t)item * 4096, TX, 65, SSC);
    { bf16* XS = WSP(bf16, WS_XS); for (int e = tid; e < 64 * 64; e += 512) { const int t = e >> 6, p = e & 63; XS[(size_t)(row0 + t) * 512 + hh * 64 + p] = (bf16)f2bf(TX[t * 65 + p]); } }
    if (c == NCH - 1) conv_state_out(C, C.out + O_PSSDC + (size_t)(l * 4 + b) * 3 * 1024, 1024, b, C_XBC + hh * 64, hh * 64, 64);
    __syncthreads();
}

DI void s5_load_consts(const Ctx& C, int l, int g, float& lre, float& lim, float (&bb)[32]) {
    const float* T = WSP(float, WS_S5T + (size_t)l * S5T_LAYER); const int gn = g * 64 + C.lane;
    lre = T[gn * 2]; lim = T[gn * 2 + 1];
    const f32x4* B4 = (const f32x4*)(T + 32 * 64 * 2 + (size_t)gn * 32);
#pragma unroll
    for (int q = 0; q < 8; ++q) { const f32x4 v = B4[q]; bb[4 * q] = v[0]; bb[4 * q + 1] = v[1]; bb[4 * q + 2] = v[2]; bb[4 * q + 3] = v[3]; }
}
DI void s5_stage_load(const bf16* P0, int nrows, int lane, v4u& u0, v4u& u1) {
    if (lane < nrows) { u0 = *(const v4u*)(P0 + (size_t)lane * LDP); u1 = *(const v4u*)(P0 + (size_t)lane * LDP + 8); }
}
DI void s5_stage_store(LAS float* US, int nrows, int lane, const v4u& u0, const v4u& u1) {
    if (lane < nrows) {
        f32x4 a, b, c, d;
        a[0] = pg8::bf_lo(u0.x); a[1] = pg8::bf_hi(u0.x); a[2] = pg8::bf_lo(u0.y); a[3] = pg8::bf_hi(u0.y); b[0] = pg8::bf_lo(u0.z); b[1] = pg8::bf_hi(u0.z); b[2] = pg8::bf_lo(u0.w); b[3] = pg8::bf_hi(u0.w);
        c[0] = pg8::bf_lo(u1.x); c[1] = pg8::bf_hi(u1.x); c[2] = pg8::bf_lo(u1.y); c[3] = pg8::bf_hi(u1.y); d[0] = pg8::bf_lo(u1.z); d[1] = pg8::bf_hi(u1.z); d[2] = pg8::bf_lo(u1.w); d[3] = pg8::bf_hi(u1.w);
        LAS f32x4* dst = (LAS f32x4*)(US + lane * 16); dst[0] = a; dst[1] = b; dst[2] = c; dst[3] = d;
    }
}
DI void s5_stage_u(LAS float* US, const bf16* P0, int nrows, int lane) { v4u u0 = {0u, 0u, 0u, 0u}, u1 = {0u, 0u, 0u, 0u}; s5_stage_load(P0, nrows, lane, u0, u1); s5_stage_store(US, nrows, lane, u0, u1); }
DI void s5_step(const LAS float* urow  , const float (&bb)[32], float lre, float lim, float& hre, float& him) {
    const LAS f32x4* u4 = (const LAS f32x4*)urow; const f32x4 a = u4[0], b = u4[1], c = u4[2], d = u4[3];
    const float uf[16] = {a[0], a[1], a[2], a[3], b[0], b[1], b[2], b[3], c[0], c[1], c[2], c[3], d[0], d[1], d[2], d[3]};
    float dr[4] = {0.f, 0.f, 0.f, 0.f}, di[4] = {0.f, 0.f, 0.f, 0.f};
#pragma unroll
    for (int k = 0; k < 16; ++k) { dr[k & 3] += bb[k] * uf[k]; di[k & 3] += bb[16 + k] * uf[k]; }
    const float dre = (dr[0] + dr[1]) + (dr[2] + dr[3]), dim = (di[0] + di[1]) + (di[2] + di[3]);
    const float nre = lre * hre - lim * him + dre, nim = lre * him + lim * hre + dim; hre = nre; him = nim;
}
DI void s5_prep_item(const Ctx& C0, int l, int item) {
    Ctx C = C0; C.tid = (int)threadIdx.x; C.lane = C.tid & 63; C.lds = lds_base(); asm volatile("" : "+v"(C.tid), "+v"(C.lane), "+v"(C.lds), "+s"(C.a), "+s"(C.ws), "+s"(C.out));
    const int g = item & 31, c = (item >> 5) & 31, b = item >> 10;
    LAS float* US = (LAS float*)(C.lds + C.wave * WAVE_LDS);
    float lre, lim, bb[32]; s5_load_consts(C, l, g, lre, lim, bb);
    s5_stage_u(US, WSP(bf16, WS_P) + (size_t)(b * SEQ + 64 * c) * LDP + C_S5U + g * 16, 64, C.lane);
    LDS_WAIT(); asm volatile("" ::: "memory");
    float hre = 0.f, him = 0.f;
#pragma unroll 8
    for (int t = 0; t < 64; ++t) s5_step(US + t * 16, bb, lre, lim, hre, him);
    f32x2 o; o.x = hre; o.y = him; *(f32x2*)(WSP(float, WS_LEND) + ((size_t)item * 64 + C.lane) * 2) = o;
    LDS_WAIT(); asm volatile("" ::: "memory");
}

DI void prep_phase(const Ctx& C, int l) {
    int oz = 0; asm volatile("" : "+s"(oz));
    for (int it = C.vcu + oz; it < 2304; it += C.G) {
        int n1 = (DUP_PHASE == 11) ? 2 : 1, n2 = (DUP_PHASE == 12) ? 2 : 1, n3 = (DUP_PHASE == 13) ? 2 : 1; asm volatile("" : "+s"(n1), "+s"(n2), "+s"(n3));
        if (it < 512) { for (int q = 0; q < n1; ++q) gdn_prep_item(C, l, it); }
        else if (it < 1024) { for (int q = 0; q < n2; ++q) ret_prep_item(C, l, it - 512); }
        else if (it < 1280) { for (int q = 0; q < n3; ++q) ssdg_prep_item(C, l, it - 1024); }
        else {
            TileRaw<64> rx; { Ctx Cq = C; Cq.tid = (int)threadIdx.x; asm volatile("" : "+v"(Cq.tid)); ssdh_ld(Cq, l, it - 1280, rx); }
            for (; it < 2304; it += C.G) { const int nx = it + C.G < 2304 ? it + C.G - 1280 : -1; Ctx Cq = C; Cq.tid = (int)threadIdx.x; asm volatile("" : "+v"(Cq.tid)); ssdh_prep_item(Cq, l, it - 1280, rx, nx); }
            break;
        }
    }
    const int gw = C.vcu * NWAVES + C.wave + oz, NGW = C.G * NWAVES;
    { int n4 = (DUP_PHASE == 14) ? 2 : 1; asm volatile("" : "+s"(n4));
      for (int it = gw; it < 4 * 32 * 32; it += NGW) for (int q = 0; q < n4; ++q) s5_prep_item(C, l, it); }
}
#ifndef DUP_PHASE
#define DUP_PHASE -1
#endif
#ifndef OLD_DIST
#define OLD_DIST 0
#endif
#ifndef OLD_WALK
#define OLD_WALK 0
#endif
#ifndef EN_WALK
#define EN_WALK 255
#endif

template <typename T> DI T ldu(const void* ubase, unsigned loff, int cbytes) { return *(const T*)((const char*)ubase + cbytes + loff); }
template <typename T> DI void stu(void* ubase, unsigned loff, int cbytes, T v) { *(T*)((char*)ubase + cbytes + loff) = v; }
DI bf16x8 ldfu_nat(const void* ubase, unsigned loff, int cbytes) { return ldu<bf16x8>(ubase, loff, cbytes); }
DI bf16x8 ldfu_perm(const void* ubase, unsigned loff, int cbytes) { const s16x4 lo = ldu<s16x4>(ubase, loff, cbytes), hi = ldu<s16x4>(ubase, loff, cbytes + 16); return __builtin_shufflevector(lo, hi, 0, 1, 2, 3, 4, 5, 6, 7); }
constexpr int CR(int reg) { return (reg & 3) + 8 * (reg >> 2); }

DI void gdn_walk(const Ctx& C0, int l, int wi) {
    Ctx C = C0; C.tid = (int)threadIdx.x; C.lane = C.tid & 63; C.lds = lds_base(); asm volatile("" : "+v"(C.tid), "+v"(C.lane), "+v"(C.lds), "+s"(C.a), "+s"(C.ws), "+s"(C.out));
    const int slice = wi & 3, bh = wi >> 2, hh = bh & 3, b = bh >> 2, lane = C.lane, r = lane & 31, h = lane >> 5, dv0 = 32 * slice;
    const unsigned lo_a128 = (unsigned)(r * 128 + 4 * h) * 2u;
    const unsigned lo_a64 = (unsigned)(r * 64 + 4 * h) * 2u;
    const unsigned lo_u = (unsigned)(4 * h * 128 + dv0 + r) * 4u;
    const unsigned lo_g = (unsigned)(4 * h) * 4u;
    const unsigned lo_o = (unsigned)(4 * h * 1536 + hh * 128 + dv0 + r) * 4u;
    f32x16 S[4];
#pragma unroll
    for (int i = 0; i < 4; ++i) S[i] = zero16();
#pragma unroll 1
    for (int c = 0; c < NCH; ++c) {
        const size_t idx = (size_t)bh * 32 + c;
        const bf16* W = WSP(bf16, WS_GW) + idx * 8192; const bf16* Q = WSP(bf16, WS_GQ) + idx * 8192; const bf16* SC = WSP(bf16, WS_GSC) + idx * 4096; const bf16* KT = WSP(bf16, WS_GKT) + idx * 8192;
        const float* U = WSP(float, WS_GU) + idx * 8192; const float* G = WSP(float, WS_GG) + idx * 64;
        float* Oc = WSP(float, WS_O) + (size_t)(b * SEQ + 64 * c) * 1536;
        bf16x8 Sb[8];
#pragma unroll
        for (int dt = 0; dt < 4; ++dt) { Sb[2 * dt] = pack_step<0>(S[dt]); Sb[2 * dt + 1] = pack_step<1>(S[dt]); }
        f32x16 vn[2], o[2];
#pragma unroll
        for (int it = 0; it < 2; ++it) {
            f32x16 a = zero16(), q = zero16();
#pragma unroll
            for (int ks = 0; ks < 8; ++ks) {
                a = MFMA32(ldfu_perm(W, lo_a128, (32 * it * 128 + 16 * ks) * 2), Sb[ks], a);
                q = MFMA32(ldfu_perm(Q, lo_a128, (32 * it * 128 + 16 * ks) * 2), Sb[ks], q);
                if (ks & 1) __builtin_amdgcn_sched_barrier(0);
            }
#pragma unroll
            for (int reg = 0; reg < 16; ++reg) { vn[it][reg] = ldu<float>(U, lo_u, (32 * it + CR(reg)) * 128 * 4) - a[reg]; o[it][reg] = __expf(ldu<float>(G, lo_g, (32 * it + CR(reg)) * 4)) * q[reg]; }
            __builtin_amdgcn_sched_barrier(0);
        }
        bf16x8 vb[2][2]; vb[0][0] = pack_step<0>(vn[0]); vb[0][1] = pack_step<1>(vn[0]); vb[1][0] = pack_step<0>(vn[1]); vb[1][1] = pack_step<1>(vn[1]);
#pragma unroll
        for (int s = 0; s < 2; ++s) {
            o[0] = MFMA32(ldfu_perm(SC, lo_a64, (16 * s) * 2), vb[0][s], o[0]);
            o[1] = MFMA32(ldfu_perm(SC, lo_a64, (32 * 64 + 16 * s) * 2), vb[0][s], o[1]);
            o[1] = MFMA32(ldfu_perm(SC, lo_a64, (32 * 64 + 32 + 16 * s) * 2), vb[1][s], o[1]);
        }
        const float gl = __expf(ldu<float>(G, vzero(), 63 * 4));
#pragma unroll
        for (int dt = 0; dt < 4; ++dt) {
            S[dt] = S[dt] * gl;
#pragma unroll
            for (int it = 0; it < 2; ++it)
#pragma unroll
                for (int s = 0; s < 2; ++s) S[dt] = MFMA32(ldfu_perm(KT, lo_a64, (32 * dt * 64 + 32 * it + 16 * s) * 2), vb[it][s], S[dt]);
            if (dt & 1) __builtin_amdgcn_sched_barrier(0);
        }
#pragma unroll
        for (int it = 0; it < 2; ++it)
#pragma unroll
            for (int reg = 0; reg < 16; ++reg) stu<float>(Oc, lo_o, (32 * it + CR(reg)) * 1536 * 4, o[it][reg]);
    }
    float* so = C.out + O_PGDN + ((size_t)(l * 4 + b) * 4 + hh) * 128 * 128;
    const unsigned lo_s = (unsigned)(4 * h * 128 + dv0 + r) * 4u;
#pragma unroll
    for (int dt = 0; dt < 4; ++dt)
#pragma unroll
        for (int reg = 0; reg < 16; ++reg) stu<float>(so, lo_s, (32 * dt + CR(reg)) * 128 * 4, S[dt][reg]);
}

template <int DV> DI void la_walk(const Ctx& C, const bf16* Qb, const bf16* Kb, const bf16* KTb, const bf16* VTb, const bf16* VDb, const float* Gb, const float* DTb, int dv0,
                float* O  , float* so  ) {
    const int lane = C.lane, r = lane & 31, h = lane >> 5;
    const unsigned lo_n128 = (unsigned)(r * 128 + 8 * h) * 2u, lo_p128 = (unsigned)(r * 128 + 4 * h) * 2u;
    const unsigned lo_n64 = (unsigned)(r * 64 + 8 * h) * 2u;
    const unsigned lo_vn = (unsigned)((dv0 + r) * 64 + 8 * h) * 2u, lo_vp = (unsigned)((dv0 + r) * 64 + 4 * h) * 2u;
    const unsigned lo_g = (unsigned)(4 * h) * 4u, lo_gi = (unsigned)r * 4u;
    const unsigned lo_o = (unsigned)(4 * h * 1536 + dv0 + r) * 4u;
    f32x16 S[4];
#pragma unroll
    for (int i = 0; i < 4; ++i) S[i] = zero16();
#pragma unroll 1
    for (int c = 0; c < NCH; ++c) {
        const bf16* Q = Qb + (size_t)c * 8192; const bf16* K = Kb + (size_t)c * 8192; const bf16* KT = KTb + (size_t)c * 8192;
        const bf16* VT = VTb + (size_t)c * DV * 64; const bf16* VD = VDb + (size_t)c * DV * 64; const float* G = Gb + c * 64; const float* DT = DTb + c * 64;
        float* Oc = O + (size_t)(64 * c) * 1536;
        f32x16 s00 = zero16(), s01 = zero16(), s11 = zero16();
#pragma unroll
        for (int ks = 0; ks < 8; ++ks) {
            const bf16x8 k0 = ldfu_nat(K, lo_n128, (16 * ks) * 2), k1 = ldfu_nat(K, lo_n128, (32 * 128 + 16 * ks) * 2), q0 = ldfu_nat(Q, lo_n128, (16 * ks) * 2), q1 = ldfu_nat(Q, lo_n128, (32 * 128 + 16 * ks) * 2);
            s00 = MFMA32(k0, q0, s00); s01 = MFMA32(k0, q1, s01); s11 = MFMA32(k1, q1, s11);
            if (ks & 1) __builtin_amdgcn_sched_barrier(0);
        }
        const float Gi0 = ldu<float>(G, lo_gi, 0), Gi1 = ldu<float>(G, lo_gi, 32 * 4);
#pragma unroll
        for (int reg = 0; reg < 16; ++reg) { const int j0 = CR(reg) + 4 * h;
            const float Gj0 = ldu<float>(G, lo_g, CR(reg) * 4), Gj1 = ldu<float>(G, lo_g, (32 + CR(reg)) * 4), d0 = ldu<float>(DT, lo_g, CR(reg) * 4), d1 = ldu<float>(DT, lo_g, (32 + CR(reg)) * 4);
            s00[reg] = (r >= j0) ? s00[reg] * d0 * __expf(Gi0 - Gj0) : 0.f;
            s01[reg] = s01[reg] * d0 * __expf(Gi1 - Gj0);
            s11[reg] = (r >= j0) ? s11[reg] * d1 * __expf(Gi1 - Gj1) : 0.f; }
        __builtin_amdgcn_sched_barrier(0);
        f32x16 o0 = zero16(), o1 = zero16();
        { const bf16x8 p00a = pack_step<0>(s00), p00b = pack_step<1>(s00), p01a = pack_step<0>(s01), p01b = pack_step<1>(s01), p11a = pack_step<0>(s11), p11b = pack_step<1>(s11);
          const bf16x8 v00 = ldfu_perm(VT, lo_vp, 0), v01 = ldfu_perm(VT, lo_vp, 32), v10 = ldfu_perm(VT, lo_vp, 64), v11 = ldfu_perm(VT, lo_vp, 96);
          o0 = MFMA32(p00a, v00, o0); o0 = MFMA32(p00b, v01, o0);
          o1 = MFMA32(p01a, v00, o1); o1 = MFMA32(p01b, v01, o1); o1 = MFMA32(p11a, v10, o1); o1 = MFMA32(p11b, v11, o1); }
        __builtin_amdgcn_sched_barrier(0);
        {
            bf16x8 Sb[8];
#pragma unroll
            for (int dt = 0; dt < 4; ++dt) { Sb[2 * dt] = pack_step<0>(S[dt]); Sb[2 * dt + 1] = pack_step<1>(S[dt]); }
            f32x16 q0 = zero16(), q1 = zero16();
#pragma unroll
            for (int ks = 0; ks < 8; ++ks) { q0 = MFMA32(ldfu_perm(Q, lo_p128, (16 * ks) * 2), Sb[ks], q0); q1 = MFMA32(ldfu_perm(Q, lo_p128, (32 * 128 + 16 * ks) * 2), Sb[ks], q1); if ((ks & 3) == 3) __builtin_amdgcn_sched_barrier(0); }
#pragma unroll
            for (int reg = 0; reg < 16; ++reg) { o0[reg] += __expf(ldu<float>(G, lo_g, CR(reg) * 4)) * q0[reg]; o1[reg] += __expf(ldu<float>(G, lo_g, (32 + CR(reg)) * 4)) * q1[reg]; }
        }
        __builtin_amdgcn_sched_barrier(0);
        const float gl = __expf(ldu<float>(G, vzero(), 63 * 4));
        { const bf16x8 d0 = ldfu_nat(VD, lo_vn, 0), d1 = ldfu_nat(VD, lo_vn, 32), d2 = ldfu_nat(VD, lo_vn, 64), d3 = ldfu_nat(VD, lo_vn, 96);
#pragma unroll
          for (int dt = 0; dt < 4; ++dt) {
            S[dt] = S[dt] * gl;
            S[dt] = MFMA32(ldfu_nat(KT, lo_n64, (32 * dt * 64) * 2), d0, S[dt]); S[dt] = MFMA32(ldfu_nat(KT, lo_n64, (32 * dt * 64 + 16) * 2), d1, S[dt]);
            S[dt] = MFMA32(ldfu_nat(KT, lo_n64, (32 * dt * 64 + 32) * 2), d2, S[dt]); S[dt] = MFMA32(ldfu_nat(KT, lo_n64, (32 * dt * 64 + 48) * 2), d3, S[dt]); if (dt & 1) __builtin_amdgcn_sched_barrier(0); } }
#pragma unroll
        for (int reg = 0; reg < 16; ++reg) { stu<float>(Oc, lo_o, CR(reg) * 1536 * 4, o0[reg]); stu<float>(Oc, lo_o, (32 + CR(reg)) * 1536 * 4, o1[reg]); }
    }
    const unsigned lo_s = (unsigned)(4 * h * DV + dv0 + r) * 4u;
#pragma unroll
    for (int dt = 0; dt < 4; ++dt)
#pragma unroll
        for (int reg = 0; reg < 16; ++reg) stu<float>(so, lo_s, (32 * dt + CR(reg)) * DV * 4, S[dt][reg]);
}
DI void ret_walk(const Ctx& C0, int l, int wi) {
    Ctx C = C0; C.tid = (int)threadIdx.x; C.lane = C.tid & 63; C.lds = lds_base(); asm volatile("" : "+v"(C.tid), "+v"(C.lane), "+v"(C.lds), "+s"(C.a), "+s"(C.ws), "+s"(C.out));
    const int slice = wi & 3, bh = wi >> 2, hh = bh & 3, b = bh >> 2; const size_t i0 = (size_t)bh * 32;
    la_walk<128>(C, WSP(bf16, WS_RQ) + i0 * 8192, WSP(bf16, WS_RK) + i0 * 8192, WSP(bf16, WS_RKT) + i0 * 8192, WSP(bf16, WS_RVT) + i0 * 8192, WSP(bf16, WS_RVD) + i0 * 8192,
            WSP(float, WS_RG) + i0 * 64, WSP(float, WS_RDT) + i0 * 64, 32 * slice, WSP(float, WS_O) + (size_t)b * SEQ * 1536 + 1024 + hh * 128,
            C.out + O_PRET + ((size_t)(l * 4 + b) * 4 + hh) * 128 * 128);
}
DI void ssd_walk(const Ctx& C0, int l, int wi) {
    Ctx C = C0; C.tid = (int)threadIdx.x; C.lane = C.tid & 63; C.lds = lds_base(); asm volatile("" : "+v"(C.tid), "+v"(C.lane), "+v"(C.lds), "+s"(C.a), "+s"(C.ws), "+s"(C.out));
    const int slice = wi & 1, bh = wi >> 1, hh = bh & 7, b = bh >> 3; const size_t ig = (size_t)(b * 2 + (hh >> 2)) * 32, ih = (size_t)bh * 32;
    la_walk<64>(C, WSP(bf16, WS_SQ) + ig * 8192, WSP(bf16, WS_SK) + ig * 8192, WSP(bf16, WS_SKT) + ig * 8192, WSP(bf16, WS_SVT) + ih * 4096, WSP(bf16, WS_SVD) + ih * 4096,
            WSP(float, WS_SG) + ih * 64, WSP(float, WS_SDT) + ih * 64, 32 * slice, WSP(float, WS_O) + (size_t)b * SEQ * 1536 + 512 + hh * 64,
            C.out + O_PSSD + ((size_t)(l * 4 + b) * 8 + hh) * 128 * 64);
}

constexpr int HS_LD = 132;
DI void s5_load_cq(const Ctx& C, int l, int g, float (&cq)[32]) {
    const int ch = C.lane & 15, kq = C.lane >> 4;
    const float* cre = INP(I_S5CRE) + (((size_t)l * 32 + g) * 16 + ch) * 64 + kq; const float* cim = INP(I_S5CIM) + (((size_t)l * 32 + g) * 16 + ch) * 64 + kq;
#pragma unroll
    for (int kk = 0; kk < 16; ++kk) { cq[kk] = cre[4 * kk]; cq[16 + kk] = -cim[4 * kk]; }
}
DI void s5_project(const Ctx& C, const float (&cq)[32], const LAS float* HS, int nt  , const LAS float* US0  , const float* dvec  , bf16* Yrow0) {
    const int ch = C.lane & 15, kq = C.lane >> 4;
    f32x4 acc = {0.f, 0.f, 0.f, 0.f}, acc2 = {0.f, 0.f, 0.f, 0.f};
    const LAS float* hp = HS + ch * HS_LD + kq;
    float hv[32];
#pragma unroll
    for (int kk = 0; kk < 32; ++kk) hv[kk] = hp[4 * kk];
    __builtin_amdgcn_sched_barrier(0);
#pragma unroll
    for (int kk = 0; kk < 32; kk += 2) { acc = __builtin_amdgcn_mfma_f32_16x16x4f32(hv[kk], cq[kk], acc, 0, 0, 0); acc2 = __builtin_amdgcn_mfma_f32_16x16x4f32(hv[kk + 1], cq[kk + 1], acc2, 0, 0, 0); }
    acc = acc + acc2;
    const float dv = dvec[ch];
#pragma unroll
    for (int reg = 0; reg < 4; ++reg) { const int t = 4 * kq + reg;
        if (t < nt) Yrow0[(size_t)t * 512 + ch] = (bf16)f2bf(geluf(acc[reg] + dv * US0[t * 16 + ch])); }
}
DI void s5_walk_item(const Ctx& C0, int l, int item) {
    Ctx C = C0; C.tid = (int)threadIdx.x; C.lane = C.tid & 63; C.lds = lds_base(); asm volatile("" : "+v"(C.tid), "+v"(C.lane), "+v"(C.lds), "+s"(C.a), "+s"(C.ws), "+s"(C.out));
    const int g = item & 31, cq = (item >> 5) & 7, b = item >> 8, lane = C.lane;
    LAS float* HS = (LAS float*)(C.lds + C.wave * WAVE_LDS); LAS float* US = HS + 16 * HS_LD;
    float lre, lim, bb[32], cq_[32]; s5_load_consts(C, l, g, lre, lim, bb); s5_load_cq(C, l, g, cq_);
    float pre = lre, pim = lim;
#pragma unroll
    for (int i = 0; i < 6; ++i) { const float nr = pre * pre - pim * pim, ni = 2.f * pre * pim; pre = nr; pim = ni; }
    float hre = 0.f, him = 0.f;
    { const float* LE = WSP(float, WS_LEND) + ((size_t)(b * 32) * 32 + g) * 128 + lane * 2;
      for (int q = 0; q < cq; ++q) {
        f32x2 e[4];
#pragma unroll
        for (int i = 0; i < 4; ++i) e[i] = *(const f32x2*)(LE + (size_t)(4 * q + i) * 32 * 128);
#pragma unroll
        for (int i = 0; i < 4; ++i) { const float nr = pre * hre - pim * him + e[i].x, ni = pre * him + pim * hre + e[i].y; hre = nr; him = ni; } } }
    const float* dvec = INP(I_S5D) + (size_t)l * 512 + g * 16;
    v4u un0 = {0u, 0u, 0u, 0u}, un1 = {0u, 0u, 0u, 0u};
    s5_stage_load(WSP(bf16, WS_P) + (size_t)(b * SEQ + 64 * (4 * cq)) * LDP + C_S5U + g * 16, 64, lane, un0, un1);
#pragma unroll 1
    for (int cc = 0; cc < 4; ++cc) { const int c = 4 * cq + cc;
        s5_stage_store(US, 64, lane, un0, un1);
        if (cc < 3) s5_stage_load(WSP(bf16, WS_P) + (size_t)(b * SEQ + 64 * (c + 1)) * LDP + C_S5U + g * 16, 64, lane, un0, un1);
        bf16* Y = WSP(bf16, WS_YS5) + (size_t)(b * SEQ + 64 * c) * 512 + g * 16;
        LDS_WAIT(); asm volatile("" ::: "memory");
        for (int sub = 0; sub < 4; ++sub) {
#pragma unroll
            for (int t = 0; t < 16; ++t) { s5_step(US + (16 * sub + t) * 16, bb, lre, lim, hre, him); HS[t * HS_LD + lane] = hre; HS[t * HS_LD + 64 + lane] = him; }
            LDS_WAIT(); asm volatile("" ::: "memory");
            s5_project(C, cq_, HS, 16, US + (16 * sub) * 16, dvec, Y + (size_t)(16 * sub) * 512);
            LDS_WAIT(); asm volatile("" ::: "memory");
        }
    }
    if (cq == 7) { C.out[O_PS5RE + ((size_t)(l * 4 + b) * 32 + g) * 64 + lane] = hre; C.out[O_PS5IM + ((size_t)(l * 4 + b) * 32 + g) * 64 + lane] = him; }
}
DI void s5_sample_item(const Ctx& C0, int l, int item) {
    Ctx C = C0; C.tid = (int)threadIdx.x; C.lane = C.tid & 63; C.lds = lds_base(); asm volatile("" : "+v"(C.tid), "+v"(C.lane), "+v"(C.lds), "+s"(C.a), "+s"(C.ws), "+s"(C.out));
    const int g = item & 31, b4 = item >> 5, lane = C.lane;
    LAS float* HS = (LAS float*)(C.lds + C.wave * WAVE_LDS); LAS float* US = HS + 16 * HS_LD;
    float lre, lim, bb[32], cq_[32]; s5_load_consts(C, l, g, lre, lim, bb); s5_load_cq(C, l, g, cq_);
#pragma unroll
    for (int t = ST; t < 16; ++t) { HS[t * HS_LD + lane] = 0.f; HS[t * HS_LD + 64 + lane] = 0.f; }
#pragma unroll 1
    for (int bi = 0; bi < 4; ++bi) { const int b = 4 * b4 + bi;
        s5_stage_u(US, WSP(bf16, WS_P) + (size_t)(MP + b * ST) * LDP + C_S5U + g * 16, ST, lane);
        const size_t si = ((size_t)(l * SB + b) * 32 + g) * 64 + lane;
        float hre = INP(I_S5RE)[si], him = INP(I_S5IM)[si];
        LDS_WAIT(); asm volatile("" ::: "memory");
#pragma unroll
        for (int t = 0; t < ST; ++t) { s5_step(US + t * 16, bb, lre, lim, hre, him); HS[t * HS_LD + lane] = hre; HS[t * HS_LD + 64 + lane] = him; }
        LDS_WAIT(); asm volatile("" ::: "memory");
        s5_project(C, cq_, HS, ST, US, INP(I_S5D) + (size_t)l * 512 + g * 16, WSP(bf16, WS_YS5) + (size_t)(MP + b * ST) * 512 + g * 16);
        LDS_WAIT(); asm volatile("" ::: "memory");
        C.out[O_SS5RE + si] = hre; C.out[O_SS5IM + si] = him;
    }
}

struct SC4 { float x[7], w[4], bias; };
DI void sconv4_ld(SC4& c, const bf16* Prow0, int col, const float* buf  , int CW, int chn, const float* cw, const float* cb  ) {
    c.x[0] = buf[chn]; c.x[1] = buf[CW + chn]; c.x[2] = buf[2 * CW + chn];
#pragma unroll
    for (int t = 0; t < 4; ++t) c.x[3 + t] = bf2f(Prow0[(size_t)t * LDP + col]);
    c.w[0] = cw[chn]; c.w[1] = cw[CW + chn]; c.w[2] = cw[2 * CW + chn]; c.w[3] = cw[3 * CW + chn]; c.bias = cb ? cb[chn] : 0.f;
}
DI void sconv4_fin(const SC4& c, int CW, int chn, float* outbuf  , float (&y)[4]) {
#pragma unroll
    for (int t = 0; t < 4; ++t) y[t] = siluf(c.w[0] * c.x[t] + c.w[1] * c.x[t + 1] + c.w[2] * c.x[t + 2] + c.w[3] * c.x[t + 3] + c.bias);
    if (outbuf) { outbuf[chn] = c.x[4]; outbuf[CW + chn] = c.x[5]; outbuf[2 * CW + chn] = c.x[6]; }
}
template <typename T> DI T ldu_nt(const void* ubase, unsigned loff, int cbytes) { return __builtin_nontemporal_load((const T*)((const char*)ubase + cbytes + loff)); }
template <typename T> DI void stu_nt(void* ubase, unsigned loff, int cbytes, T v) { __builtin_nontemporal_store(v, (T*)((char*)ubase + cbytes + loff)); }
template <bool GDN, int DV> DI void sample_core_w(const LAS float* QS, const LAS float* KS, const LAS float* VS, const LAS float* AB, const float* S0, float* S1, float* O  , int lane) {
    const int c32 = lane & 31, hf = lane >> 5;
    const unsigned lo = (unsigned)((hf * 64) * DV + c32) * 4u;
#pragma unroll 1
    for (int pass = 0; pass < DV / 64; ++pass) {
        const float* S0p; float* S1p;
        { const unsigned long long a0 = (unsigned long long)(S0 + pass * 64), a1 = (unsigned long long)(S1 + pass * 64);
          S0p = (const float*)(((unsigned long long)(unsigned)__builtin_amdgcn_readfirstlane((int)(a0 >> 32)) << 32) | (unsigned)__builtin_amdgcn_readfirstlane((int)a0));
          S1p = (float*)(((unsigned long long)(unsigned)__builtin_amdgcn_readfirstlane((int)(a1 >> 32)) << 32) | (unsigned)__builtin_amdgcn_readfirstlane((int)a1)); }
        const int colA = pass * 64 + c32, colB = colA + 32;
        float sA[64], sB[64];
#pragma unroll
        for (int d = 0; d < 64; ++d) { sA[d] = ldu_nt<float>(S0p, lo, d * DV * 4); sB[d] = ldu_nt<float>(S0p, lo, d * DV * 4 + 128); }
#pragma unroll 1
        for (int t = 0; t < 4; ++t) {
            const float a = AB[2 * t], beta = AB[2 * t + 1];
            const LAS float* kp = KS + t * 128 + hf * 64; const LAS float* qp = QS + t * 128 + hf * 64;
            float cvA = VS[t * DV + colA], cvB = VS[t * DV + colB];
            if (GDN) {
                float kA = 0.f, kB = 0.f;
#pragma unroll
                for (int q = 0; q < 16; ++q) { const f32x4 kv = *(const LAS f32x4*)(kp + 4 * q);
                    kA += (kv[0] * sA[4 * q] + kv[1] * sA[4 * q + 1]) + (kv[2] * sA[4 * q + 2] + kv[3] * sA[4 * q + 3]);
                    kB += (kv[0] * sB[4 * q] + kv[1] * sB[4 * q + 1]) + (kv[2] * sB[4 * q + 2] + kv[3] * sB[4 * q + 3]); if ((q & 3) == 3) __builtin_amdgcn_sched_barrier(0); }
                kA = pg8::xor32_sum(kA); kB = pg8::xor32_sum(kB);
                cvA = beta * (cvA - a * kA); cvB = beta * (cvB - a * kB);
            }
            float oA = 0.f, oB = 0.f;
#pragma unroll
            for (int q = 0; q < 16; ++q) { const f32x4 kv = *(const LAS f32x4*)(kp + 4 * q), qv = *(const LAS f32x4*)(qp + 4 * q);
#pragma unroll
                for (int e = 0; e < 4; ++e) { sA[4 * q + e] = a * sA[4 * q + e] + cvA * kv[e]; oA += qv[e] * sA[4 * q + e]; sB[4 * q + e] = a * sB[4 * q + e] + cvB * kv[e]; oB += qv[e] * sB[4 * q + e]; }
                if ((q & 3) == 3) __builtin_amdgcn_sched_barrier(0); }
            oA = pg8::xor32_sum(oA); oB = pg8::xor32_sum(oB);
            if (hf == 0) { O[(size_t)t * 1536 + colA] = oA; O[(size_t)t * 1536 + colB] = oB; }
        }
#pragma unroll
        for (int d = 0; d < 64; ++d) { stu_nt<float>(S1p, lo, d * DV * 4, sA[d]); stu_nt<float>(S1p, lo, d * DV * 4 + 128, sB[d]); }
    }
}
template <bool GDN> DI void sample_core(const LAS float* QS, const LAS float* KS, const LAS float* VS, const LAS float* AB, int DV, const float* S0, float* S1, float* O, int lane) {
    if (DV == 128) sample_core_w<GDN, 128>(QS, KS, VS, AB, S0, S1, O, lane); else sample_core_w<GDN, 64>(QS, KS, VS, AB, S0, S1, O, lane);
}
DI void gdn_sample_item(const Ctx& C0, int l, int item) {
    Ctx C = C0; C.tid = (int)threadIdx.x; C.lane = C.tid & 63; C.lds = lds_base(); asm volatile("" : "+v"(C.tid), "+v"(C.lane), "+v"(C.lds), "+s"(C.a), "+s"(C.ws), "+s"(C.out));
    const int hh = item & 3, b = item >> 2, lane = C.lane, row0 = MP + b * ST;
    LAS float* QS = (LAS float*)(C.lds + C.wave * WAVE_LDS); LAS float* KS = QS + 512; LAS float* VS = KS + 512; LAS float* AB = VS + 512;
    const bf16* Prow0 = WSP(bf16, WS_P) + (size_t)row0 * LDP;
    const float* buf = INP(I_SGDNC) + (size_t)(l * SB + b) * 3 * 1536; float* obuf = C.out + O_SGDNC + (size_t)(l * SB + b) * 3 * 1536; const float* cw = INP(I_GCW) + (size_t)l * 4 * 1536;
    SC4 cv[6];
#pragma unroll
    for (int k = 0; k < 2; ++k) { const int d = k * 64 + lane;
        sconv4_ld(cv[k], Prow0, C_GV + hh * 128 + d, buf, 1536, 1024 + hh * 128 + d, cw, nullptr);
        sconv4_ld(cv[2 + k], Prow0, C_GQ + hh * 128 + d, buf, 1536, hh * 128 + d, cw, nullptr);
        sconv4_ld(cv[4 + k], Prow0, C_GK + hh * 128 + d, buf, 1536, 512 + hh * 128 + d, cw, nullptr); }
#pragma unroll
    for (int k = 0; k < 2; ++k) { const int d = k * 64 + lane; float y[4]; sconv4_fin(cv[k], 1536, 1024 + hh * 128 + d, obuf, y);
#pragma unroll
        for (int t = 0; t < 4; ++t) VS[t * 128 + d] = y[t]; }
#pragma unroll
    for (int arr = 0; arr < 2; ++arr) {
        float y0[4], y1[4];
        sconv4_fin(cv[2 + 2 * arr], 1536, arr * 512 + hh * 128 + lane, obuf, y0);
        sconv4_fin(cv[3 + 2 * arr], 1536, arr * 512 + hh * 128 + 64 + lane, obuf, y1);
        LAS float* dst = arr == 0 ? QS : KS;
#pragma unroll
        for (int t = 0; t < 4; ++t) { const float sc = rsqrtf(wave_sum(y0[t] * y0[t] + y1[t] * y1[t]) + EPS) * (arr == 0 ? 0.08838834764831845f : 1.f); dst[t * 128 + lane] = y0[t] * sc; dst[t * 128 + 64 + lane] = y1[t] * sc; }
    }
    if (lane < 4) { const float* ps = WSP(float, WS_PS) + (size_t)(row0 + lane) * 16;
        AB[2 * lane] = __expf(-__expf(INP(I_GALOG)[l * 4 + hh]) * softplusf(ps[4 + hh] + INP(I_GDTB)[l * 4 + hh])); AB[2 * lane + 1] = sigm(ps[hh]); }
    LDS_WAIT(); asm volatile("" ::: "memory");
    sample_core<true>(QS, KS, VS, AB, 128, INP(I_SGDN) + ((size_t)(l * SB + b) * 4 + hh) * 128 * 128, C.out + O_SGDN + ((size_t)(l * SB + b) * 4 + hh) * 128 * 128,
                      WSP(float, WS_O) + (size_t)row0 * 1536 + hh * 128, lane);
    LDS_WAIT(); asm volatile("" ::: "memory");
}
DI void ret_sample_item(const Ctx& C0, int l, int item) {
    Ctx C = C0; C.tid = (int)threadIdx.x; C.lane = C.tid & 63; C.lds = lds_base(); asm volatile("" : "+v"(C.tid), "+v"(C.lane), "+v"(C.lds), "+s"(C.a), "+s"(C.ws), "+s"(C.out));
    const int hh = item & 3, b = item >> 2, lane = C.lane, row0 = MP + b * ST;
    LAS float* QS = (LAS float*)(C.lds + C.wave * WAVE_LDS); LAS float* KS = QS + 512; LAS float* VS = KS + 512; LAS float* AB = VS + 512;
    const bf16* Prow0 = WSP(bf16, WS_P) + (size_t)row0 * LDP; const float* ROT = WSP(float, WS_ROT) + (size_t)2048 * 64 * 2;
    f32x2 csr[4]; bf16 rw[4][6];
#pragma unroll
    for (int t = 0; t < 4; ++t) { csr[t] = *(const f32x2*)(ROT + ((size_t)t * 64 + lane) * 2); const bf16* pr = Prow0 + (size_t)t * LDP + hh * 128;
        rw[t][0] = pr[C_RQ + lane]; rw[t][1] = pr[C_RQ + 64 + lane]; rw[t][2] = pr[C_RK + lane]; rw[t][3] = pr[C_RK + 64 + lane]; rw[t][4] = pr[C_RV + lane]; rw[t][5] = pr[C_RV + 64 + lane]; }
#pragma unroll
    for (int t = 0; t < 4; ++t) { const f32x2 cs = csr[t];
        const float q1 = bf2f(rw[t][0]), q2 = bf2f(rw[t][1]), k1 = bf2f(rw[t][2]), k2 = bf2f(rw[t][3]);
        QS[t * 128 + lane] = q1 * cs.x - q2 * cs.y; QS[t * 128 + 64 + lane] = q1 * cs.y + q2 * cs.x;
        KS[t * 128 + lane] = (k1 * cs.x - k2 * cs.y) * 0.08838834764831845f; KS[t * 128 + 64 + lane] = (k1 * cs.y + k2 * cs.x) * 0.08838834764831845f;
        VS[t * 128 + lane] = bf2f(rw[t][4]); VS[t * 128 + 64 + lane] = bf2f(rw[t][5]); }
    if (lane < 4) { const float dg = hh == 0 ? 0.96875f : hh == 1 ? 0.984375f : hh == 2 ? 0.9921875f : 0.99609375f;     AB[2 * lane] = dg; AB[2 * lane + 1] = 0.f; }
    LDS_WAIT(); asm volatile("" ::: "memory");
    sample_core<false>(QS, KS, VS, AB, 128, INP(I_SRET) + ((size_t)(l * SB + b) * 4 + hh) * 128 * 128, C.out + O_SRET + ((size_t)(l * SB + b) * 4 + hh) * 128 * 128,
                       WSP(float, WS_O) + (size_t)row0 * 1536 + 1024 + hh * 128, lane);
    LDS_WAIT(); asm volatile("" ::: "memory");
}
DI void ssd_sample_item(const Ctx& C0, int l, int item) {
    Ctx C = C0; C.tid = (int)threadIdx.x; C.lane = C.tid & 63; C.lds = lds_base(); asm volatile("" : "+v"(C.tid), "+v"(C.lane), "+v"(C.lds), "+s"(C.a), "+s"(C.ws), "+s"(C.out));
    const int hh = item & 7, b = item >> 3, grp = hh >> 2, lane = C.lane, row0 = MP + b * ST;
    LAS float* CS = (LAS float*)(C.lds + C.wave * WAVE_LDS); LAS float* BS = CS + 512; LAS float* VS = BS + 512; LAS float* AB = VS + 512;
    const bf16* Prow0 = WSP(bf16, WS_P) + (size_t)row0 * LDP;
    const float* buf = INP(I_SSSDC) + (size_t)(l * SB + b) * 3 * 1024; float* obuf = C.out + O_SSSDC + (size_t)(l * SB + b) * 3 * 1024;
    const float* cw = INP(I_SCW) + (size_t)l * 4 * 1024; const float* cb = INP(I_SCB) + (size_t)l * 1024;
    float* ob_bc = (hh & 3) == 0 ? obuf : nullptr;
    SC4 cv[5];
#pragma unroll
    for (int k = 0; k < 4; ++k) { const int arr = k >> 1, n = (k & 1) * 64 + lane, chn = 512 + arr * 256 + grp * 128 + n; sconv4_ld(cv[k], Prow0, C_XBC + chn, buf, 1024, chn, cw, cb); }
    sconv4_ld(cv[4], Prow0, C_XBC + hh * 64 + lane, buf, 1024, hh * 64 + lane, cw, cb);
    float dtr[4];
#pragma unroll
    for (int t = 0; t < 4; ++t) dtr[t] = WSP(float, WS_PS)[(size_t)(row0 + t) * 16 + 8 + hh + vzero()];
#pragma unroll
    for (int k = 0; k < 4; ++k) {
        const int arr = k >> 1, n = (k & 1) * 64 + lane, chn = 512 + arr * 256 + grp * 128 + n;
        float y[4]; sconv4_fin(cv[k], 1024, chn, ob_bc, y);
        LAS float* dst = arr == 0 ? BS : CS;
#pragma unroll
        for (int t = 0; t < 4; ++t) dst[t * 128 + n] = y[t];
    }
    { float xs[4]; const int chn = hh * 64 + lane; sconv4_fin(cv[4], 1024, chn, obuf, xs);
#pragma unroll
      for (int t = 0; t < 4; ++t) { const float dt = softplusf(dtr[t] + INP(I_SDTB)[l * 8 + hh]);
          VS[t * 64 + lane] = xs[t] * dt; WSP(bf16, WS_XS)[(size_t)(row0 + t) * 512 + hh * 64 + lane] = (bf16)f2bf(xs[t]);
          if (lane == 0) { AB[2 * t] = __expf(-__expf(INP(I_SALOG)[l * 8 + hh]) * dt); AB[2 * t + 1] = 0.f; } } }
    LDS_WAIT(); asm volatile("" ::: "memory");
    sample_core<false>(CS, BS, VS, AB, 64, INP(I_SSSD) + ((size_t)(l * SB + b) * 8 + hh) * 128 * 64, C.out + O_SSSD + ((size_t)(l * SB + b) * 8 + hh) * 128 * 64,
                       WSP(float, WS_O) + (size_t)row0 * 1536 + 512 + hh * 64, lane);
    LDS_WAIT(); asm volatile("" ::: "memory");
}

constexpr int LD128 = 136, LD64 = 72;
template <int NCHUNK> DI void ldg_chunks(v4u (&v)[NCHUNK], const bf16* src, int t2) {
#pragma unroll
    for (int i = 0; i < NCHUNK; ++i) v[i] = *(const v4u*)(src + (size_t)(t2 + 256 * i) * 8);
}
template <int NCHUNK, int COLS, int LD> DI void sts_chunks(const v4u (&v)[NCHUNK], LAS bf16* dst, int t2) {
#pragma unroll
    for (int i = 0; i < NCHUNK; ++i) { const int ch = t2 + 256 * i, row = ch / (COLS / 8), cc = ch % (COLS / 8); *(LAS v4u*)(dst + row * LD + cc * 8) = v[i]; }
}
DI bf16x8 lds_nat(const LAS bf16* p) { return *(const LAS bf16x8*)p; }
DI bf16x8 lds_perm(const LAS bf16* p) { const s16x4 lo = *(const LAS s16x4*)p, hi = *(const LAS s16x4*)(p + 8); return __builtin_shufflevector(lo, hi, 0, 1, 2, 3, 4, 5, 6, 7); }

constexpr int GB_W = 0, GB_Q = 64 * LD128 * 2, GB_SC = 2 * 64 * LD128 * 2, GB_KT = GB_SC + 64 * LD64 * 2, GB_G = GB_KT + 128 * LD64 * 2, GB_SIZE = GB_G + 256;
static_assert(2 * GB_SIZE <= MISC_OFF, "GDN walker LDS");
DI void gdn_walk_wg(const Ctx& C0, int l, int bh) {
    Ctx C = C0; C.tid = (int)threadIdx.x; C.lane = C.tid & 63; C.lds = lds_base(); asm volatile("" : "+v"(C.tid), "+v"(C.lane), "+v"(C.lds), "+s"(C.a), "+s"(C.ws), "+s"(C.out));
    const int lane = C.lane, r = lane & 31, h = lane >> 5, wave = C.wave, hh = bh & 3, b = bh >> 2, dv0 = 32 * wave;
    const bool walker = wave < 4;
    const size_t idx0 = (size_t)bh * 32;
    if (!walker) {
        const bf16* Wg = WSP(bf16, WS_GW) + idx0 * 8192; const bf16* Qg = WSP(bf16, WS_GQ) + idx0 * 8192; const bf16* SCg = WSP(bf16, WS_GSC) + idx0 * 4096; const bf16* KTg = WSP(bf16, WS_GKT) + idx0 * 8192;
        const float* Gg = WSP(float, WS_GG) + idx0 * 64;
        v4u w[4], q[4], sc[2], kt[4]; float gv = 0.f;
        { const int t2 = C.tid - 256; ldg_chunks<4>(w, Wg, t2); ldg_chunks<4>(q, Qg, t2); ldg_chunks<2>(sc, SCg, t2); ldg_chunks<4>(kt, KTg, t2); if (t2 < 64) gv = Gg[t2]; }
#pragma unroll 1
        for (int c = -1; c < NCH; ++c) {
            int t2 = C.tid - 256; asm volatile("" : "+v"(t2));
            if (c + 1 < NCH) {
                LAS unsigned char* Bn = C.lds + ((c + 1) & 1) * GB_SIZE;
                sts_chunks<4, 128, LD128>(w, (LAS bf16*)(Bn + GB_W), t2); sts_chunks<4, 128, LD128>(q, (LAS bf16*)(Bn + GB_Q), t2); sts_chunks<2, 64, LD64>(sc, (LAS bf16*)(Bn + GB_SC), t2); sts_chunks<4, 64, LD64>(kt, (LAS bf16*)(Bn + GB_KT), t2);
                if (t2 < 64) ((LAS float*)(Bn + GB_G))[t2] = gv;
            }
            if (c + 2 < NCH) { const size_t cn = (size_t)(c + 2);
                ldg_chunks<4>(w, Wg + cn * 8192, t2); ldg_chunks<4>(q, Qg + cn * 8192, t2); ldg_chunks<2>(sc, SCg + cn * 4096, t2); ldg_chunks<4>(kt, KTg + cn * 8192, t2); if (t2 < 64) gv = Gg[cn * 64 + t2]; }
            __syncthreads();
        }
    } else {
        const float* Ug = WSP(float, WS_GU) + idx0 * 8192;
        f32x16 S[4];
#pragma unroll
        for (int i = 0; i < 4; ++i) S[i] = zero16();
        const unsigned lo_u = (unsigned)(4 * h * 128 + dv0 + r) * 4u, lo_o = (unsigned)(4 * h * 1536 + hh * 128 + dv0 + r) * 4u;
        f32x16 vn[2];
#pragma unroll
        for (int it = 0; it < 2; ++it)
#pragma unroll
            for (int reg = 0; reg < 16; ++reg) vn[it][reg] = ldu<float>(Ug, lo_u, (32 * it + CR(reg)) * 128 * 4);
        __syncthreads();
#pragma unroll 1
        for (int c = 0; c < NCH; ++c) {
            LAS unsigned char* B = C.lds + (c & 1) * GB_SIZE;
            const LAS bf16* W = (const LAS bf16*)(B + GB_W) + r * LD128 + 4 * h; const LAS bf16* Q = (const LAS bf16*)(B + GB_Q) + r * LD128 + 4 * h;
            const LAS bf16* SC = (const LAS bf16*)(B + GB_SC) + r * LD64 + 4 * h; const LAS bf16* KT = (const LAS bf16*)(B + GB_KT) + r * LD64 + 4 * h;
            const LAS float* G = (const LAS float*)(B + GB_G) + 4 * h;
            float* Oc = WSP(float, WS_O) + (size_t)(b * SEQ + 64 * c) * 1536;
            f32x16 o[2];
            bf16x8 Sb[8];
#pragma unroll
            for (int dt = 0; dt < 4; ++dt) { Sb[2 * dt] = pack_step<0>(S[dt]); Sb[2 * dt + 1] = pack_step<1>(S[dt]); }
#pragma unroll
            for (int it = 0; it < 2; ++it) {
                f32x16 a = zero16(), q = zero16();
#pragma unroll
                for (int kh = 0; kh < 2; ++kh) {
                    bf16x8 wf[4], qf[4];
#pragma unroll
                    for (int k4 = 0; k4 < 4; ++k4) { wf[k4] = lds_perm(W + 32 * it * LD128 + 16 * (4 * kh + k4)); qf[k4] = lds_perm(Q + 32 * it * LD128 + 16 * (4 * kh + k4)); }
                    __builtin_amdgcn_sched_barrier(0);
#pragma unroll
                    for (int k4 = 0; k4 < 4; ++k4) { a = MFMA32(wf[k4], Sb[4 * kh + k4], a); q = MFMA32(qf[k4], Sb[4 * kh + k4], q); }
                    __builtin_amdgcn_sched_barrier(0);
                }
#pragma unroll
                for (int reg = 0; reg < 16; ++reg) { vn[it][reg] -= a[reg]; o[it][reg] = __expf(G[32 * it + CR(reg)]) * q[reg]; }
                __builtin_amdgcn_sched_barrier(0);
            }
            bf16x8 vb[2][2]; vb[0][0] = pack_step<0>(vn[0]); vb[0][1] = pack_step<1>(vn[0]); vb[1][0] = pack_step<0>(vn[1]); vb[1][1] = pack_step<1>(vn[1]);
            { bf16x8 sf[2][3];
#pragma unroll
              for (int s = 0; s < 2; ++s) { sf[s][0] = lds_perm(SC + 16 * s); sf[s][1] = lds_perm(SC + 32 * LD64 + 16 * s); sf[s][2] = lds_perm(SC + 32 * LD64 + 32 + 16 * s); }
              __builtin_amdgcn_sched_barrier(0);
#pragma unroll
              for (int s = 0; s < 2; ++s) { o[0] = MFMA32(sf[s][0], vb[0][s], o[0]); o[1] = MFMA32(sf[s][1], vb[0][s], o[1]); o[1] = MFMA32(sf[s][2], vb[1][s], o[1]); } }
            const float gl = __expf(G[63 - 4 * h]);
#pragma unroll
            for (int dp = 0; dp < 2; ++dp) {
                bf16x8 kf[2][2][2];
#pragma unroll
                for (int e = 0; e < 2; ++e)
#pragma unroll
                    for (int it = 0; it < 2; ++it)
#pragma unroll
                        for (int s = 0; s < 2; ++s) kf[e][it][s] = lds_perm(KT + 32 * (2 * dp + e) * LD64 + 32 * it + 16 * s);
                S[2 * dp] = S[2 * dp] * gl; S[2 * dp + 1] = S[2 * dp + 1] * gl;
                __builtin_amdgcn_sched_barrier(0);
#pragma unroll
                for (int it = 0; it < 2; ++it)
#pragma unroll
                    for (int s = 0; s < 2; ++s) { S[2 * dp] = MFMA32(kf[0][it][s], vb[it][s], S[2 * dp]); S[2 * dp + 1] = MFMA32(kf[1][it][s], vb[it][s], S[2 * dp + 1]); }
                __builtin_amdgcn_sched_barrier(0);
            }
#pragma unroll
            for (int it = 0; it < 2; ++it)
#pragma unroll
                for (int reg = 0; reg < 16; ++reg) stu<float>(Oc, lo_o, (32 * it + CR(reg)) * 1536 * 4, o[it][reg]);
            if (c + 1 < NCH) { const float* U = Ug + (size_t)(c + 1) * 8192;
#pragma unroll
                for (int it = 0; it < 2; ++it)
#pragma unroll
                    for (int reg = 0; reg < 16; ++reg) vn[it][reg] = ldu<float>(U, lo_u, (32 * it + CR(reg)) * 128 * 4); }
            __syncthreads();
        }
        float* so = C.out + O_PGDN + ((size_t)(l * 4 + b) * 4 + hh) * 128 * 128;
        const unsigned lo_s = (unsigned)(4 * h * 128 + dv0 + r) * 4u;
#pragma unroll
        for (int dt = 0; dt < 4; ++dt)
#pragma unroll
            for (int reg = 0; reg < 16; ++reg) stu<float>(so, lo_s, (32 * dt + CR(reg)) * 128 * 4, S[dt][reg]);
    }
}

constexpr int LB_Q = 0, LB_K = 64 * LD128 * 2, LB_KT = 2 * 64 * LD128 * 2, LB_SIZE = LB_KT + 128 * LD64 * 2, LV_VT = 2 * LB_SIZE, LV_VD = LV_VT + 128 * LD64 * 2, LV_G = LV_VD + 128 * LD64 * 2, LV_END = LV_G + 2 * 2 * 2 * 256;
static_assert(LV_END <= MISC_OFF, "LA walker LDS");
template <bool SSD> DI void la_walk_wg(const Ctx& C0, int l, int wg  ) {
    Ctx C = C0; C.tid = (int)threadIdx.x; C.lane = C.tid & 63; C.lds = lds_base(); asm volatile("" : "+v"(C.tid), "+v"(C.lane), "+v"(C.lds), "+s"(C.a), "+s"(C.ws), "+s"(C.out));
    const int lane = C.lane, r = lane & 31, h = lane >> 5, wave = C.wave;
    const bool walker = wave < 4;
    const int b = wg >> 2, grp = (wg >> 1) & 1, pair = wg & 1, hA = SSD ? grp * 4 + pair * 2 : (wg & 3);
    if (!walker) {
        __builtin_amdgcn_s_setprio(3);
        const size_t ig = SSD ? (size_t)(b * 2 + grp) * 32 : (size_t)wg * 32, ihA = SSD ? (size_t)(b * 8 + hA) * 32 : (size_t)wg * 32;
        const bf16* Qg = SSD ? WSP(bf16, WS_SQ) + ig * 8192 : WSP(bf16, WS_RQ) + ig * 8192; const bf16* Kg = SSD ? WSP(bf16, WS_SK) + ig * 8192 : WSP(bf16, WS_RK) + ig * 8192;
        const bf16* KTg = SSD ? WSP(bf16, WS_SKT) + ig * 8192 : WSP(bf16, WS_RKT) + ig * 8192;
        const bf16* VTg = SSD ? WSP(bf16, WS_SVT) + ihA * 4096 : WSP(bf16, WS_RVT) + ihA * 8192; const bf16* VDg = SSD ? WSP(bf16, WS_SVD) + ihA * 4096 : WSP(bf16, WS_RVD) + ihA * 8192;
        const float* Gg = SSD ? WSP(float, WS_SG) + ihA * 64 : WSP(float, WS_RG) + ihA * 64; const float* DTg = SSD ? WSP(float, WS_SDT) + ihA * 64 : WSP(float, WS_RDT) + ihA * 64;
        v4u q[4], k[4], kt[4], vt[4], vd[4]; float gv = 0.f, dv = 0.f;
#define LA_LOAD_QK(cn) do { ldg_chunks<4>(q, Qg + (size_t)(cn) * 8192, t2); ldg_chunks<4>(k, Kg + (size_t)(cn) * 8192, t2); ldg_chunks<4>(kt, KTg + (size_t)(cn) * 8192, t2); \
            if (t2 < 128) { const int hd2 = t2 >> 6, j = t2 & 63; const bool ok = (hd2 == 0 || SSD); gv = ok ? Gg[(size_t)hd2 * 32 * 64 + (size_t)(cn) * 64 + j] : 0.f; dv = ok ? DTg[(size_t)hd2 * 32 * 64 + (size_t)(cn) * 64 + j] : 0.f; } } while (0)
#define LA_STORE_QK(cn) do { LAS unsigned char* Bn = C.lds + ((cn) & 1) * LB_SIZE; \
            sts_chunks<4, 128, LD128>(q, (LAS bf16*)(Bn + LB_Q), t2); sts_chunks<4, 128, LD128>(k, (LAS bf16*)(C.lds + LB_K), t2); sts_chunks<4, 64, LD64>(kt, (LAS bf16*)(Bn + LB_KT), t2); \
            if (t2 < 128) { LAS float* Gn = (LAS float*)(C.lds + LV_G) + ((cn) & 1) * 128; Gn[t2] = gv; Gn[256 + t2] = dv; } } while (0)
#define LA_LOAD_V(cn) do { if (SSD) { ldg_chunks<2>(*(v4u(*)[2])&vt[0], VTg + (size_t)(cn) * 4096, t2); ldg_chunks<2>(*(v4u(*)[2])&vt[2], VTg + (size_t)32 * 4096 + (size_t)(cn) * 4096, t2); \
                                       ldg_chunks<2>(*(v4u(*)[2])&vd[0], VDg + (size_t)(cn) * 4096, t2); ldg_chunks<2>(*(v4u(*)[2])&vd[2], VDg + (size_t)32 * 4096 + (size_t)(cn) * 4096, t2); } \
            else { ldg_chunks<4>(vt, VTg + (size_t)(cn) * 8192, t2); ldg_chunks<4>(vd, VDg + (size_t)(cn) * 8192, t2); } } while (0)
#define LA_STORE_V() do { if (SSD) { sts_chunks<2, 64, LD64>(*(const v4u(*)[2])&vt[0], (LAS bf16*)(C.lds + LV_VT), t2); sts_chunks<2, 64, LD64>(*(const v4u(*)[2])&vt[2], (LAS bf16*)(C.lds + LV_VT) + 64 * LD64, t2); \
                                      sts_chunks<2, 64, LD64>(*(const v4u(*)[2])&vd[0], (LAS bf16*)(C.lds + LV_VD), t2); sts_chunks<2, 64, LD64>(*(const v4u(*)[2])&vd[2], (LAS bf16*)(C.lds + LV_VD) + 64 * LD64, t2); } \
            else { sts_chunks<4, 64, LD64>(vt, (LAS bf16*)(C.lds + LV_VT), t2); sts_chunks<4, 64, LD64>(vd, (LAS bf16*)(C.lds + LV_VD), t2); } } while (0)
#define LA_COMPUTE_P(cn) do { const int lw = wave - 4; if (lw < 3) { const LAS unsigned char* Bn = C.lds + ((cn) & 1) * LB_SIZE; \
            const LAS bf16* Kp = (const LAS bf16*)(C.lds + LB_K) + r * LD128 + 8 * h + (lw == 2 ? 32 * LD128 : 0); const LAS bf16* Qp = (const LAS bf16*)(Bn + LB_Q) + r * LD128 + 8 * h + (lw == 0 ? 0 : 32 * LD128); \
            bf16x8 kf[8], qf[8];                              \
            _Pragma("unroll") for (int ks = 0; ks < 8; ++ks) { kf[ks] = lds_nat(Kp + 16 * ks); qf[ks] = lds_nat(Qp + 16 * ks); } \
            f32x16 sc = zero16(), sc2 = zero16();             \
            _Pragma("unroll") for (int ks = 0; ks < 8; ks += 2) { sc = MFMA32(kf[ks], qf[ks], sc); sc2 = MFMA32(kf[ks + 1], qf[ks + 1], sc2); } \
            sc = sc + sc2; \
            _Pragma("unroll") for (int hd2 = 0; hd2 < (SSD ? 2 : 1); ++hd2) { const LAS float* Gh = (const LAS float*)(C.lds + LV_G) + ((cn) & 1) * 128 + hd2 * 64; const LAS float* DTh = Gh + 256; \
                const float Gi = Gh[(lw == 0 ? 0 : 32) + r]; f32x16 tt; \
                _Pragma("unroll") for (int reg = 0; reg < 16; ++reg) { const int j0 = CR(reg) + 4 * h, jj = (lw == 2 ? 32 : 0) + j0; const float v = sc[reg] * DTh[jj] * __expf(Gi - Gh[jj]); tt[reg] = (lw == 1 || r >= j0) ? v : 0.f; } \
                LAS v4u* dst = (LAS v4u*)(C.lds + LB_SIZE + LB_K) + hd2 * 384 + lw * 128 + lane; \
                dst[0] = __builtin_bit_cast(v4u, pack_step<0>(tt)); dst[64] = __builtin_bit_cast(v4u, pack_step<1>(tt)); } } } while (0)
        { int t2 = C.tid - 256; asm volatile("" : "+v"(t2));
          LA_LOAD_QK(0); LA_LOAD_V(0); LA_STORE_QK(0); LA_STORE_V(); LA_LOAD_QK(1); LA_LOAD_V(1); }
        __syncthreads();
        LA_COMPUTE_P(0);
        __syncthreads();
#pragma unroll 1
        for (int c = 0; c < NCH; ++c) {
            int t2 = C.tid - 256; asm volatile("" : "+v"(t2));
            if (c + 1 < NCH) LA_STORE_QK(c + 1);
            if (c + 2 < NCH) LA_LOAD_QK(c + 2);
            __syncthreads();
            if (c + 1 < NCH) { LA_COMPUTE_P(c + 1); }
            __syncthreads();
            if (c + 1 < NCH) LA_STORE_V();
            if (c + 2 < NCH) LA_LOAD_V(c + 2);
        }
        __builtin_amdgcn_s_setprio(0);
#undef LA_LOAD_QK
#undef LA_STORE_QK
#undef LA_LOAD_V
#undef LA_STORE_V
#undef LA_COMPUTE_P
    } else {
        f32x16 S[4];
#pragma unroll
        for (int i = 0; i < 4; ++i) S[i] = zero16();
        const int hd = SSD ? (wave >> 1) & 1 : 0;
        const int ocol = SSD ? 512 + (hA + hd) * 64 + 32 * (wave & 1) : 1024 + hA * 128 + 32 * wave;
        const unsigned lo_o = (unsigned)(4 * h * 1536 + ocol + r) * 4u;
        const LAS v4u* PL = (const LAS v4u*)(C.lds + LB_SIZE + LB_K) + hd * 384 + lane;
        __syncthreads();
        __syncthreads();
#pragma unroll 1
        for (int c = 0; c < NCH; ++c) {
            LAS unsigned char* B = C.lds + (c & 1) * LB_SIZE;
            const LAS float* G = (const LAS float*)(C.lds + LV_G) + (c & 1) * 128 + hd * 64; const LAS float* DT = G + 256;
            v4u pp[6];
#pragma unroll
            for (int th = 0; th < 6; ++th) pp[th] = PL[th * 64];
            f32x16 q0 = zero16(), q1 = zero16();
            {
                const LAS bf16* Qp = (const LAS bf16*)(B + LB_Q) + r * LD128 + 4 * h;
                bf16x8 Sb[8];
#pragma unroll
                for (int dt = 0; dt < 4; ++dt) { Sb[2 * dt] = pack_step<0>(S[dt]); Sb[2 * dt + 1] = pack_step<1>(S[dt]); }
                bf16x8 qa[8], qb[8];
#pragma unroll
                for (int ks = 0; ks < 8; ++ks) { qa[ks] = lds_perm(Qp + 16 * ks); qb[ks] = lds_perm(Qp + 32 * LD128 + 16 * ks); }
                __builtin_amdgcn_sched_barrier(0);
#pragma unroll
                for (int ks = 0; ks < 8; ++ks) { q0 = MFMA32(qa[ks], Sb[ks], q0); q1 = MFMA32(qb[ks], Sb[ks], q1); }
                __builtin_amdgcn_sched_barrier(0);
#pragma unroll
                for (int reg = 0; reg < 16; ++reg) { q0[reg] *= __expf(G[CR(reg) + 4 * h]); q1[reg] *= __expf(G[32 + CR(reg) + 4 * h]); }
            }
            __syncthreads();
            {
                const LAS bf16* KT = (const LAS bf16*)(B + LB_KT) + r * LD64 + 8 * h;
                const LAS bf16* VTp = (const LAS bf16*)(C.lds + LV_VT) + (32 * wave + r) * LD64 + 4 * h; const LAS bf16* VDn = (const LAS bf16*)(C.lds + LV_VD) + (32 * wave + r) * LD64 + 8 * h;
                float* Oc = WSP(float, WS_O) + (size_t)(b * SEQ + 64 * c) * 1536;
                f32x16 o0 = q0, o1 = q1;
                { const bf16x8 p00a = __builtin_bit_cast(bf16x8, pp[0]), p00b = __builtin_bit_cast(bf16x8, pp[1]), p01a = __builtin_bit_cast(bf16x8, pp[2]), p01b = __builtin_bit_cast(bf16x8, pp[3]), p11a = __builtin_bit_cast(bf16x8, pp[4]), p11b = __builtin_bit_cast(bf16x8, pp[5]);
                  const bf16x8 v00 = lds_perm(VTp), v01 = lds_perm(VTp + 16), v10 = lds_perm(VTp + 32), v11 = lds_perm(VTp + 48);
                  o0 = MFMA32(p00a, v00, o0); o0 = MFMA32(p00b, v01, o0);
                  o1 = MFMA32(p01a, v00, o1); o1 = MFMA32(p01b, v01, o1); o1 = MFMA32(p11a, v10, o1); o1 = MFMA32(p11b, v11, o1); }
                __builtin_amdgcn_sched_barrier(0);
                const float gl = __expf(G[63]);
                { const bf16x8 d0 = lds_nat(VDn), d1 = lds_nat(VDn + 16), d2 = lds_nat(VDn + 32), d3 = lds_nat(VDn + 48);
#pragma unroll
                  for (int dp = 0; dp < 2; ++dp) {
                    bf16x8 kf[2][4];
#pragma unroll
                    for (int e = 0; e < 2; ++e)
#pragma unroll
                        for (int s4 = 0; s4 < 4; ++s4) kf[e][s4] = lds_nat(KT + 32 * (2 * dp + e) * LD64 + 16 * s4);
                    S[2 * dp] = S[2 * dp] * gl; S[2 * dp + 1] = S[2 * dp + 1] * gl;
                    __builtin_amdgcn_sched_barrier(0);
                    S[2 * dp] = MFMA32(kf[0][0], d0, S[2 * dp]); S[2 * dp + 1] = MFMA32(kf[1][0], d0, S[2 * dp + 1]); S[2 * dp] = MFMA32(kf[0][1], d1, S[2 * dp]); S[2 * dp + 1] = MFMA32(kf[1][1], d1, S[2 * dp + 1]);
                    S[2 * dp] = MFMA32(kf[0][2], d2, S[2 * dp]); S[2 * dp + 1] = MFMA32(kf[1][2], d2, S[2 * dp + 1]); S[2 * dp] = MFMA32(kf[0][3], d3, S[2 * dp]); S[2 * dp + 1] = MFMA32(kf[1][3], d3, S[2 * dp + 1]);
                    __builtin_amdgcn_sched_barrier(0); } }
#pragma unroll
                for (int reg = 0; reg < 16; ++reg) { stu<float>(Oc, lo_o, CR(reg) * 1536 * 4, o0[reg]); stu<float>(Oc, lo_o, (32 + CR(reg)) * 1536 * 4, o1[reg]); }
            }
            __syncthreads();
        }
        constexpr int DVH = SSD ? 64 : 128;
        float* so = SSD ? C.out + O_PSSD + ((size_t)(l * 4 + b) * 8 + hA + hd) * 128 * 64 : C.out + O_PRET + ((size_t)(l * 4 + b) * 4 + hA) * 128 * 128;
        const int scol = SSD ? 32 * (wave & 1) : 32 * wave;
        const unsigned lo_s = (unsigned)(4 * h * DVH + scol + r) * 4u;
#pragma unroll
        for (int dt = 0; dt < 4; ++dt)
#pragma unroll
            for (int reg = 0; reg < 16; ++reg) stu<float>(so, lo_s, (32 * dt + CR(reg)) * DVH * 4, S[dt][reg]);
    }
}

constexpr int NWALK_WG = 48;
DI void walk_phase(const Ctx& C, int l, int part = 3) {
#if OLD_DIST
    {
        const bool is_walker = (C.wave == 0 && C.vcu < 192);
        if (is_walker) { int wi = C.vcu; asm volatile("" : "+s"(wi)); if (wi < 64) gdn_walk(C, l, wi); else if (wi < 128) ret_walk(C, l, wi - 64); else ssd_walk(C, l, wi - 128); return; }
        int oz = 0; asm volatile("" : "+s"(oz));
        const int nwalk_before = C.vcu < 192 ? C.vcu + 1 : 192;
        const int gw = C.vcu * NWAVES + C.wave - nwalk_before + oz, NGW = C.G * NWAVES - 192;
        constexpr int N_GS = SB * 4, N_RS = SB * 4, N_SS = SB * 8, N_S5W = 4 * 8 * 32, N_S5S = (SB / 4) * 32, TOT = N_GS + N_RS + N_SS + N_S5W + N_S5S;
        for (int it = gw; it < TOT; it += NGW) {
            int r = it;
            if (r < N_GS) { gdn_sample_item(C, l, r); continue; } r -= N_GS;
            if (r < N_RS) { ret_sample_item(C, l, r); continue; } r -= N_RS;
            if (r < N_SS) { ssd_sample_item(C, l, r); continue; } r -= N_SS;
            if (r < N_S5W) { s5_walk_item(C, l, r); continue; } r -= N_S5W;
            s5_sample_item(C, l, r);
        }
        return;
    }
#endif
    const int bxw = (int)blockIdx.x;
    if (bxw < NWALK_WG) {
        if (!(part & 1)) return;
        int wi = bxw; asm volatile("" : "+s"(wi));
        if ((part & 4) && wi >= 16) return;
        if ((part & 8) && wi < 16) return;
        if (wi < 16) { if (OLD_WALK & 1) { if (C.wave < 4) gdn_walk(C, l, wi * 4 + C.wave); } else gdn_walk_wg(C, l, wi); }
        else if (wi < 32) { if (OLD_WALK & 2) { if (C.wave < 4) ret_walk(C, l, (wi - 16) * 4 + C.wave); } else la_walk_wg<false>(C, l, wi - 16); }
        else { if (OLD_WALK & 4) { if (C.wave < 4) { const int g2 = wi - 32, bb = g2 >> 2, hA = ((g2 >> 1) & 1) * 4 + (g2 & 1) * 2; ssd_walk(C, l, ((bb * 8 + hA + (C.wave >> 1)) * 2) + (C.wave & 1)); } } else la_walk_wg<true>(C, l, wi - 32); }
        return;
    }
    if (!(part & 2)) return;
    int oz = 0; asm volatile("" : "+s"(oz));
    const int gw = (bxw - NWALK_WG) * NWAVES + C.wave + oz, NGW = (C.G - NWALK_WG) * NWAVES;
    constexpr int N_GS = SB * 4, N_RS = SB * 4, N_SS = SB * 8, N_S5W = 4 * 8 * 32, N_S5S = (SB / 4) * 32, N_SMALL = N_GS + N_RS + N_SS + N_S5S;
    if (NGW > N_S5W + 64) {
        constexpr int NX = 0;
        if (gw < N_S5W) { int nr5 = (DUP_PHASE == 6) ? 2 : 1; asm volatile("" : "+s"(nr5)); for (int q = 0; q < nr5; ++q) s5_walk_item(C, l, gw);
            if (N_S5S == N_S5W) { s5_sample_item(C, l, gw); if (gw < NX) ssd_sample_item(C, l, N_SS - 1 - gw); return; } }
        const int g2 = gw - N_S5W, NG2 = NGW - N_S5W;
        for (int it = g2; it < (N_S5S == N_S5W ? N_SMALL - N_S5S - NX : N_SMALL); it += NG2) {
            int r = it; int nrs = (DUP_PHASE == 7) ? 2 : 1; asm volatile("" : "+s"(nrs));
            if (r < N_GS) { for (int q = 0; q < nrs; ++q) gdn_sample_item(C, l, r); continue; } r -= N_GS;
            if (r < N_RS) { for (int q = 0; q < nrs; ++q) ret_sample_item(C, l, r); continue; } r -= N_RS;
            if (r < N_SS) { for (int q = 0; q < nrs; ++q) ssd_sample_item(C, l, r); continue; } r -= N_SS;
            s5_sample_item(C, l, r);
        }
        return;
    }
    for (int it = gw; it < N_SMALL + N_S5W; it += NGW) {
        int r = it;
        if (r < N_GS) { gdn_sample_item(C, l, r); continue; } r -= N_GS;
        if (r < N_RS) { ret_sample_item(C, l, r); continue; } r -= N_RS;
        if (r < N_SS) { ssd_sample_item(C, l, r); continue; } r -= N_SS;
        if (r < N_S5W) { s5_walk_item(C, l, r); continue; } r -= N_S5W;
        s5_sample_item(C, l, r);
    }
}

DI void post_rows(const Ctx& C0, int l, int wg0  ) {
    Ctx C = C0; C.tid = (int)threadIdx.x; C.lane = C.tid & 63; C.lds = lds_base(); asm volatile("" : "+v"(C.tid), "+v"(C.lane), "+v"(C.lds), "+s"(C.a), "+s"(C.ws), "+s"(C.out));
    int oz = 0; asm volatile("" : "+s"(oz));
    const int bxr = (int)blockIdx.x;
    if (bxr < wg0) return;
    const int gw = (bxr - wg0) * NWAVES + C.wave + oz, NGW = (C.G - wg0) * NWAVES, lane = C.lane;
    const float* O = WSP(float, WS_O); const bf16* P = WSP(bf16, WS_P); bf16* MIX = WSP(bf16, WS_MIX); const bf16* XS = WSP(bf16, WS_XS);
    const float* gnw = INP(I_GNW) + (size_t)l * 128; const float* snw = INP(I_SNW) + (size_t)l * 512; const float* sd = INP(I_SD) + (size_t)l * 8;
    const float* rlw = INP(I_RLW) + (size_t)l * 512; const float* rlb = INP(I_RLB) + (size_t)l * 512;
    for (int row = gw; row < M; row += NGW) {
        const float* o = O + (size_t)row * 1536; const bf16* p = P + (size_t)row * LDP; bf16* mx = MIX + (size_t)row * DM;
        f32x2 og[4], orr[4]; unsigned zg[4], gr[4]; f32x4 os[2]; v2u xw[2], zs[2];
#pragma unroll
        for (int hh = 0; hh < 4; ++hh) { og[hh] = *(const f32x2*)(o + hh * 128 + 2 * lane); zg[hh] = *(const unsigned*)(p + C_GZ + hh * 128 + 2 * lane);
            orr[hh] = *(const f32x2*)(o + 1024 + hh * 128 + 2 * lane); gr[hh] = *(const unsigned*)(p + C_RG + hh * 128 + 2 * lane); }
#pragma unroll
        for (int grp = 0; grp < 2; ++grp) { const int ch = grp * 256 + 4 * lane; os[grp] = *(const f32x4*)(o + 512 + ch); xw[grp] = *(const v2u*)(XS + (size_t)row * 512 + ch); zs[grp] = *(const v2u*)(p + C_CZ + ch); }
#pragma unroll
        for (int hh = 0; hh < 4; ++hh) {
            const f32x2 v = og[hh]; const float rs = rsqrtf(wave_sum(v.x * v.x + v.y * v.y) * (1.f / 128.f) + EPS);
            const unsigned zw = zg[hh]; const f32x2 w = *(const f32x2*)(gnw + 2 * lane);
            *(unsigned*)(mx + 512 + hh * 128 + 2 * lane) = pk2(v.x * rs * w.x * siluf(pg8::bf_lo(zw)), v.y * rs * w.y * siluf(pg8::bf_hi(zw)));
        }
#pragma unroll
        for (int grp = 0; grp < 2; ++grp) {
            const int ch = grp * 256 + 4 * lane; const f32x4 y = os[grp]; const v2u xv = xw[grp]; const v2u zw = zs[grp];
            const float D = sd[ch >> 6];
            f32x4 t; t[0] = (y[0] + pg8::bf_lo(xv.x) * D) * siluf(pg8::bf_lo(zw.x)); t[1] = (y[1] + pg8::bf_hi(xv.x) * D) * siluf(pg8::bf_hi(zw.x));
            t[2] = (y[2] + pg8::bf_lo(xv.y) * D) * siluf(pg8::bf_lo(zw.y)); t[3] = (y[3] + pg8::bf_hi(xv.y) * D) * siluf(pg8::bf_hi(zw.y));
            const float rs = rsqrtf(wave_sum((t[0] * t[0] + t[1] * t[1]) + (t[2] * t[2] + t[3] * t[3])) * (1.f / 256.f) + EPS); const f32x4 w = *(const f32x4*)(snw + ch);
            v2u ow; ow.x = pk2(t[0] * rs * w[0], t[1] * rs * w[1]); ow.y = pk2(t[2] * rs * w[2], t[3] * rs * w[3]); *(v2u*)(mx + 1024 + ch) = ow;
        }
#pragma unroll
        for (int hh = 0; hh < 4; ++hh) {
            const int ch = hh * 128 + 2 * lane; const f32x2 v = orr[hh]; const float mu = wave_sum(v.x + v.y) * (1.f / 128.f);
            const float d0 = v.x - mu, d1 = v.y - mu; const float rs = rsqrtf(wave_sum(d0 * d0 + d1 * d1) * (1.f / 128.f) + EPS);
            const unsigned gwd = gr[hh]; const f32x2 w = *(const f32x2*)(rlw + ch), bb = *(const f32x2*)(rlb + ch);
            *(unsigned*)(mx + 1536 + ch) = pk2((d0 * rs * w.x + bb.x) * siluf(pg8::bf_lo(gwd)), (d1 * rs * w.y + bb.y) * siluf(pg8::bf_hi(gwd)));
        }
    }
}
DI void final_rows(const Ctx& C0) {
    Ctx C = C0; C.tid = (int)threadIdx.x; C.lane = C.tid & 63; C.lds = lds_base(); asm volatile("" : "+v"(C.tid), "+v"(C.lane), "+v"(C.lds), "+s"(C.a), "+s"(C.ws), "+s"(C.out));
    const int gw = C.vcu * NWAVES + C.wave, NGW = C.G * NWAVES, lane = C.lane;
    const bf16* XB = WSP(bf16, WS_XB); const ull* ssq = WSP(ull, SSQ_OFF) + (size_t)6 * M; const float* nf = INP(I_NFIN);
    for (int row0 = gw; row0 < MP; row0 += 2 * NGW) {
        v2u hw[2][8]; float rs[2];
#pragma unroll
        for (int r = 0; r < 2; ++r) { const int row = row0 + r * NGW; rs[r] = pg8::rs_from_ssq(ssq, (row < MP ? row : row0) + (int)vzero());
#pragma unroll
            for (int j = 0; j < 8; ++j) hw[r][j] = *(const v2u*)(XB + (size_t)(row < MP ? row : row0) * DM + 256 * j + 4 * lane); }
#pragma unroll
        for (int r = 0; r < 2; ++r) { const int row = row0 + r * NGW; if (row < MP) {
#pragma unroll
            for (int j = 0; j < 8; ++j) { const f32x4 w = *(const f32x4*)(nf + 256 * j + 4 * lane);
                f32x4 v; v[0] = pg8::bf_lo(hw[r][j].x); v[1] = pg8::bf_hi(hw[r][j].x); v[2] = pg8::bf_lo(hw[r][j].y); v[3] = pg8::bf_hi(hw[r][j].y); __builtin_nontemporal_store(v * rs[r] * w, (f32x4*)(C.out + (size_t)row * DM + 256 * j + 4 * lane)); } } }
    }
}

typedef _Float16 f16x4 __attribute__((ext_vector_type(4)));
DI f32x4 ld_h4(const unsigned short* p) { const f16x4 h = *(const f16x4*)p; return __builtin_convertvector(h, f32x4); }
DI void sample_reduce(const Ctx& C0, int mode, int NS, const float* base  , ull* ssq_out, const ull* ssq_in, bf16* XO, int wg0, int nwg, unsigned* flag) {
    Ctx C = C0; C.tid = (int)threadIdx.x; C.lane = C.tid & 63; C.lds = lds_base(); asm volatile("" : "+v"(C.tid), "+v"(C.lane), "+v"(C.lds), "+s"(C.a), "+s"(C.ws), "+s"(C.out));
    int oz = 0; asm volatile("" : "+s"(oz));
    const int gw = ((int)blockIdx.x - wg0) * NWAVES + C.wave + oz, NGW = nwg * NWAVES, lane = C.lane;
    const unsigned short* SL = WSP(unsigned short, WS_O); float* H = WSP(float, WS_H); const bf16* PP = WSP(bf16, WS_PP);
    for (int rr = gw; rr < MS; rr += NGW) {
        const int row = MP + rr; float ss = 0.f;
        const float rs = mode ? pg8::rs_from_ssq(ssq_in, row + (int)vzero()) : 1.f;
        f32x4 a[8];
#pragma unroll
        for (int j = 0; j < 8; ++j) a[j] = (f32x4){0.f, 0.f, 0.f, 0.f};
#pragma unroll 4
        for (int sl = 0; sl < NS; ++sl) {
#pragma unroll
            for (int j = 0; j < 8; ++j) a[j] += ld_h4(SL + ((size_t)sl * 512 + rr) * 2048 + 256 * j + 4 * lane);
        }
        f32x4 bv[8]; v2u pw[8];
#pragma unroll
        for (int j = 0; j < 8; ++j) { const int col = 256 * j + 4 * lane;
            if (mode == 0) bv[j] = *(const f32x4*)(base + (size_t)rr * DM + col);
            else { bv[j] = *(const f32x4*)(H + (size_t)row * DM + col); pw[j] = *(const v2u*)(PP + (size_t)row * DM + col); } }
#pragma unroll
        for (int j = 0; j < 8; ++j) { const int col = 256 * j + 4 * lane;
            f32x4 o;
            if (mode == 0) { o = bv[j] + a[j]; }
            else { const f32x4 hv = bv[j]; const f32x4 g = a[j] * rs;
                o[0] = hv[0] + sigm(g[0]) * pg8::bf_lo(pw[j].x); o[1] = hv[1] + sigm(g[1]) * pg8::bf_hi(pw[j].x); o[2] = hv[2] + sigm(g[2]) * pg8::bf_lo(pw[j].y); o[3] = hv[3] + sigm(g[3]) * pg8::bf_hi(pw[j].y); }
            *(f32x4*)(H + (size_t)row * DM + col) = o;
            ss += (o[0] * o[0] + o[1] * o[1]) + (o[2] * o[2] + o[3] * o[3]);
            v2u x; x.x = pk2(o[0], o[1]); x.y = pk2(o[2], o[3]); *(v2u*)(XO + (size_t)row * DM + col) = x;
        }
        ss = wave_sum(ss);
        if (lane == 0) ssq_out[row] = (ull)(ss * pg8::SSQ_SCALE + 0.5f);
    }
    asm volatile("s_waitcnt vmcnt(0)" ::: "memory"); __syncthreads();
    if (C.tid == 0) { __builtin_amdgcn_fence(__ATOMIC_RELEASE, "agent"); asm volatile("s_waitcnt vmcnt(0)" ::: "memory"); (void)__hip_atomic_fetch_add(flag, 1u, __ATOMIC_RELAXED, __HIP_MEMORY_SCOPE_AGENT); }
}
DI void sample_final(const Ctx& C0, const ull* ssq_in) {
    Ctx C = C0; C.tid = (int)threadIdx.x; C.lane = C.tid & 63; C.lds = lds_base(); asm volatile("" : "+v"(C.tid), "+v"(C.lane), "+v"(C.lds), "+s"(C.a), "+s"(C.ws), "+s"(C.out));
    int oz = 0; asm volatile("" : "+s"(oz));
    const int gw = C.vcu * NWAVES + C.wave + oz, lane = C.lane;
    if (gw >= MS) return;
    const unsigned short* SL = WSP(unsigned short, WS_O); const float* H = WSP(float, WS_H); const bf16* PP = WSP(bf16, WS_PP); const float* nf = INP(I_NFIN);
    const int rr = gw, row = MP + rr; float ss = 0.f;
    const float rs = pg8::rs_from_ssq(ssq_in, row + (int)vzero());
    f32x4 ov[8];
#pragma unroll
    for (int j = 0; j < 8; ++j) { const int col = 256 * j + 4 * lane;
        f32x4 a = {0.f, 0.f, 0.f, 0.f};
#pragma unroll
        for (int sl = 0; sl < 8; ++sl) a += ld_h4(SL + ((size_t)sl * 512 + rr) * 2048 + col);
        const f32x4 hv = *(const f32x4*)(H + (size_t)row * DM + col); const v2u pw = *(const v2u*)(PP + (size_t)row * DM + col); a = a * rs;
        f32x4 o; o[0] = hv[0] + sigm(a[0]) * pg8::bf_lo(pw.x); o[1] = hv[1] + sigm(a[1]) * pg8::bf_hi(pw.x); o[2] = hv[2] + sigm(a[2]) * pg8::bf_lo(pw.y); o[3] = hv[3] + sigm(a[3]) * pg8::bf_hi(pw.y);
        ss += (o[0] * o[0] + o[1] * o[1]) + (o[2] * o[2] + o[3] * o[3]); ov[j] = o; }
    ss = wave_sum(ss);
    const float rf = rsqrtf((float)(ull)(ss * pg8::SSQ_SCALE + 0.5f) * (1.0f / (pg8::SSQ_SCALE * 2048.0f)) + 1e-6f);
#pragma unroll
    for (int j = 0; j < 8; ++j) { const f32x4 w = *(const f32x4*)(nf + 256 * j + 4 * lane); __builtin_nontemporal_store(ov[j] * rf * w, (f32x4*)(C.out + (size_t)row * DM + 256 * j + 4 * lane)); }
}

#ifndef DUP_PHASE
#define DUP_PHASE -1
#endif
#ifndef EN_P0
#define EN_P0 1
#endif
#ifndef EN_PREP
#define EN_PREP 31
#endif
#ifndef EN_WALK
#define EN_WALK 255
#endif
#ifndef EN_POST
#define EN_POST 1
#endif
#ifndef EN_GLU
#define EN_GLU 1
#endif
#ifndef EN_PPG
#define EN_PPG 1
#endif
#ifndef EN_GEMM
#define EN_GEMM 63
#endif
__global__ void __launch_bounds__(NWAVES * 64, 2) hybrid_fwd(Args args) {
    extern __shared__ __attribute__((aligned(16))) unsigned char lds[];
    Ctx C;
    C.lds = (LAS unsigned char*)lds; C.ws = args.ws; C.out = args.out; C.a = (const CAS Args*)__builtin_amdgcn_kernarg_segment_ptr();
    C.tid = threadIdx.x; C.lane = C.tid & 63; C.wave = __builtin_amdgcn_readfirstlane(C.tid >> 6);
    C.G = gridDim.x; { const int bx = blockIdx.x; C.vcu = (C.G % 8 == 0) ? (bx % 8) * (C.G / 8) + bx / 8 : bx; }
    volatile LAS unsigned* MISC = (volatile LAS unsigned*)(C.lds + MISC_OFF);
    for (int u = C.tid; u < (LDS_BYTES - MISC_OFF) / 4; u += NWAVES * 64) ((LAS unsigned*)(C.lds + MISC_OFF))[u] = 0u;
    __syncthreads();
    XcdBarrier bar; bar.bar = (unsigned*)(C.ws) + CW_BAR; bar.x = 0; bar.st = nullptr;
    if (!MK_PER_PHASE) bar = xcd_barrier_post((unsigned*)(C.ws) + CW_BAR, MISC + 8);
    const int lo = args.ph_lo, hi = args.ph_hi;
#define IN(k) (lo <= (k) && (k) < hi)
#define SEAM(k) do { if (IN(k) && IN((k) + 1)) { xcd_barrier(bar); if (DUP_PHASE == 10) xcd_barrier(bar); } } while (0)
    const int bx = (int)blockIdx.x;

    if (EN_P0 && IN(0)) { p0_prologue(C); if (DUP_PHASE == 0) { xcd_barrier(bar); p0_prologue(C); } } SEAM(0);
#pragma unroll 1
    for (int l = 0; l < 2; ++l) {
        const int pb = 1 + 8 * l;
        if ((EN_GEMM & 1) && IN(pb + 0)) {
            unsigned char* wsq = C.ws; const CAS Args* ap = C.a; int bxq = bx, Gq = C.G; asm volatile("" : "+s"(wsq), "+s"(ap), "+s"(bxq), "+s"(Gq)); unsigned char* wl = wsq + WS_W + (size_t)l * WL_BYTES; ull* ssq = (ull*)(wsq + SSQ_OFF);
            if (l > 0 && bxq >= 192) sample_reduce(C, 1, 8, nullptr, ssq + (size_t)(3 * l) * M, ssq + (size_t)(3 * l - 1) * M, (bf16*)(wsq + WS_XB), 192, 64, (unsigned*)wsq + CW_DEP + 64 * (3 * l - 1));
            pg8::Gemm g{(const pg8::bf16_t*)(wsq + WS_XB), (const pg8::bf16_t*)(wl + WO_IN), M, NINP, DM, DM}; pg8::StaticOrder S; S.init(M, NINP, Gq, bxq);
            if (l > 0) { S.dflag = (const unsigned*)wsq + CW_DEP + 64 * (3 * l - 1); S.dtarget = 64; S.dpm = 32; }
            pg8::EpiProj E{(pg8::bf16_t*)(wsq + WS_P), (float*)(wsq + WS_PS), ssq + (size_t)(3 * l) * M};
            int nrep = (DUP_PHASE == 8) ? 2 : 1; asm volatile("" : "+s"(nrep));
            for (int rep = 0; rep < nrep; ++rep) pg8::gemm_phase<pg8::EpiProj, pg8::StaticOrder, true, true>(C.lds, g, S, E);
            if (bxq >= 82) {
                pg8::Gemm g2{(const pg8::bf16_t*)(wsq + WS_PEMB + (size_t)l * M * PLE * 2), (const pg8::bf16_t*)(wl + WO_PP), M, DM, PLE, PLE}; pg8::StaticOrder S2; S2.init(M, DM, Gq - 82, bxq - 82);
                pg8::EpiPlain E2{(pg8::bf16_t*)(wsq + WS_PP), DM};
                int nrep2 = (DUP_PHASE == 19) ? 5 : 1; asm volatile("" : "+s"(nrep2));
                for (int rep = 0; rep < nrep2; ++rep) pg8::gemm_phase<pg8::EpiPlain, pg8::StaticOrder, true, true>(C.lds, g2, S2, E2);
            }
        }
        SEAM(pb + 0);
        if (EN_PREP && IN(pb + 1)) { prep_phase(C, l); if (DUP_PHASE == 1) { xcd_barrier(bar); prep_phase(C, l); } }
        SEAM(pb + 1);
        if (EN_WALK && IN(pb + 2)) {
            int nrep = (DUP_PHASE == 2 || DUP_PHASE == 4 || DUP_PHASE == 5 || DUP_PHASE == 20 || DUP_PHASE == 21) ? 2 : 1; asm volatile("" : "+s"(nrep));
            for (int rep = 0; rep < nrep; ++rep) { if (rep) xcd_barrier(bar); walk_phase(C, l, rep == 0 ? 3 : (DUP_PHASE == 4 ? 2 : DUP_PHASE == 5 ? 1 : DUP_PHASE == 20 ? 5 : DUP_PHASE == 21 ? 9 : 3)); }
        }
        SEAM(pb + 2);
        if ((EN_GEMM & 2) && IN(pb + 3)) {
            unsigned char* wsq = C.ws; const CAS Args* ap = C.a; int bxq = bx, Gq = C.G; asm volatile("" : "+s"(wsq), "+s"(ap), "+s"(bxq), "+s"(Gq)); unsigned char* wl = wsq + WS_W + (size_t)l * WL_BYTES; ull* ssq = (ull*)(wsq + SSQ_OFF);
            if (EN_GLU) { pg8::Gemm g{(const pg8::bf16_t*)(wsq + WS_YS5), (const pg8::bf16_t*)(wl + WO_GLU), M, 512, 512, 512}; pg8::StaticOrder S; S.init(M, 512, Gq, bxq);
              pg8::EpiGlu E{(const pg8::bf16_t*)(wsq + WS_YS5), (pg8::bf16_t*)(wsq + WS_MIX), ap->in[I_S5BG] + (size_t)l * 512};
              int nrep = (DUP_PHASE == 17) ? 2 : 1; asm volatile("" : "+s"(nrep));
              for (int rep = 0; rep < nrep; ++rep) pg8::gemm_phase<pg8::EpiGlu, pg8::StaticOrder, true, true>(C.lds, g, S, E); }
            if (EN_POST) post_rows(C, l, 68);
            if (DUP_PHASE == 3) { xcd_barrier(bar); post_rows(C, l, 68); }
        }
        SEAM(pb + 3);
#pragma unroll 1
        for (int t = 0; t < 3; ++t) {
            const int pm_ = pb + (t == 0 ? 4 : t == 1 ? 6 : 7);
            if (t == 1) {
                if ((EN_GEMM & 8) && IN(pb + 5)) {
                    unsigned char* wsq = C.ws; const CAS Args* ap = C.a; int bxq = bx, Gq = C.G; asm volatile("" : "+s"(wsq), "+s"(ap), "+s"(bxq), "+s"(Gq)); unsigned char* wl = wsq + WS_W + (size_t)l * WL_BYTES; ull* ssq = (ull*)(wsq + SSQ_OFF);
                    if (bxq >= 216) sample_reduce(C, 0, 8, l == 0 ? ap->in[I_XS] : (const float*)(wsq + WS_H) + (size_t)MP * DM, ssq + (size_t)(3 * l + 1) * M, nullptr, (bf16*)(wsq + WS_XA), 216, 40, (unsigned*)wsq + CW_DEP + 64 * (3 * l));
                    pg8::Gemm g{(const pg8::bf16_t*)(wsq + WS_XA), (const pg8::bf16_t*)(wl + WO_FI), M, 2 * FF, DM, DM}; pg8::StaticOrder S; S.init(M, 2 * FF, Gq, bxq);
                    S.dflag = (const unsigned*)wsq + CW_DEP + 64 * (3 * l); S.dtarget = 40; S.dpm = 32;
                    pg8::EpiSwiGLU E{(pg8::bf16_t*)(wsq + WS_P), ssq + (size_t)(3 * l + 1) * M};
                    int nrep = (DUP_PHASE == 9) ? 2 : 1; asm volatile("" : "+s"(nrep));
                    for (int rep = 0; rep < nrep; ++rep) pg8::gemm_phase<pg8::EpiSwiGLU, pg8::StaticOrder, true, true>(C.lds, g, S, E);
                }
                SEAM(pb + 5);
            }
            if ((EN_GEMM & 4) && IN(pm_)) {
                unsigned char* wsq = C.ws; const CAS Args* ap = C.a; int bxq = bx, Gq = C.G; asm volatile("" : "+s"(wsq), "+s"(ap), "+s"(bxq), "+s"(Gq)); unsigned char* wl = wsq + WS_W + (size_t)l * WL_BYTES; ull* ssq = (ull*)(wsq + SSQ_OFF);
                const pg8::bf16_t* Aop = (const pg8::bf16_t*)(wsq + (t == 0 ? WS_MIX : t == 1 ? WS_P : WS_XA)); const pg8::bf16_t* Bop = (const pg8::bf16_t*)(wl + (t == 0 ? WO_OUT : t == 1 ? WO_FO : WO_PG));
                const int Kfull = t == 1 ? FF : DM, NS = t == 1 ? 11 : 8;
                if (t == 2 && bxq >= 192) sample_reduce(C, 0, 11, (const float*)(wsq + WS_H) + (size_t)MP * DM, ssq + (size_t)(3 * l + 2) * M, nullptr, (bf16*)(wsq + WS_XA), 192, 64, (unsigned*)wsq + CW_DEP + 64 * (3 * l + 1));
                if (t < 2) {
                    pg8::Gemm g{Aop, Bop, MP, DM, Kfull, Kfull}; pg8::StaticOrder S; S.init(MP, DM, Gq, bxq);
                    pg8::EpiResidF E{(const pg8::bf16_t*)(wsq + (t == 0 ? WS_XB : WS_XA)), (pg8::bf16_t*)(wsq + WS_XA), ssq + (size_t)(3 * l + 1 + t) * M};
                    pg8::gemm_phase<pg8::EpiResidF, pg8::StaticOrder, false, true>(C.lds, g, S, E);
                } else {
                    pg8::Gemm g{Aop, Bop, MP, DM, Kfull, Kfull}; pg8::StaticOrder S; S.init(MP, DM, Gq, bxq);
                    pg8::EpiPleF E{(const pg8::bf16_t*)(wsq + WS_XA), (const pg8::bf16_t*)(wsq + WS_PP), (pg8::bf16_t*)(wsq + WS_XB), ssq + (size_t)(3 * l + 2) * M, ssq + (size_t)(3 * l + 3) * M};
                    pg8::gemm_phase<pg8::EpiPleF, pg8::StaticOrder, false, true>(C.lds, g, S, E);
                }
                if (DUP_PHASE == 15) { pg8::Gemm g{Aop, Bop, MP, DM, Kfull, Kfull}; pg8::StaticOrder S; S.init(MP, DM, Gq, bxq); pg8::EpiNull E{}; pg8::gemm_phase<pg8::EpiNull, pg8::StaticOrder, true, true>(C.lds, g, S, E); }
                {
                    pg8::Gemm g{Aop, Bop, M, DM, t == 1 ? 512 : 256, Kfull}; pg8::SliceOrder S; S.init(32, 2, DM, NS, Gq, bxq);
                    if (t == 2) { S.dflag = (const unsigned*)wsq + CW_DEP + 64 * (3 * l + 1); S.dtarget = 64; S.dpm = 32; }
                    pg8::EpiPartial E{(unsigned short*)(wsq + WS_O)};
                    int nrep = (DUP_PHASE == 16) ? 2 : 1; asm volatile("" : "+s"(nrep));
                    for (int rep = 0; rep < nrep; ++rep) pg8::gemm_phase<pg8::EpiPartial, pg8::SliceOrder, true, true>(C.lds, g, S, E);
                }
            }
            SEAM(pm_);
        }
    }
    if (IN(17)) { unsigned char* wsq = C.ws; asm volatile("" : "+s"(wsq)); sample_final(C, (const ull*)(wsq + SSQ_OFF) + (size_t)5 * M); int nrep = (DUP_PHASE == 18) ? 8 : 1; asm volatile("" : "+s"(nrep)); for (int rep = 0; rep < nrep; ++rep) final_rows(C); }
#undef IN
#undef SEAM
}

extern "C" void kernel_launch(void* const* d_in, const int* in_sizes, int n_in, void* d_out, int out_size, void* d_ws, size_t ws_size, hipStream_t stream) {
    static int grid = 0;
    if (grid == 0) {
        if (n_in != N_IN || (size_t)out_size != O_END || ws_size < WS_END) { fprintf(stderr, "kernel_launch: built for %d inputs, %zu outputs, >= %zu bytes of workspace; got %d, %d, %zu; nothing launched\n", (int)N_IN, (size_t)O_END, (size_t)WS_END, n_in, out_size, ws_size); grid = -1; return; }
        int dev = 0, cus = 0;
        if (hipGetDevice(&dev) != hipSuccess || hipDeviceGetAttribute(&cus, hipDeviceAttributeMultiprocessorCount, dev) != hipSuccess) { grid = -1; return; }
        if (hipFuncSetAttribute((const void*)hybrid_fwd, hipFuncAttributeMaxDynamicSharedMemorySize, LDS_BYTES) != hipSuccess) { fprintf(stderr, "kernel_launch: hipFuncSetAttribute failed\n"); grid = -1; return; }
        (void)hipGetLastError();
        if (cus != 256) { fprintf(stderr, "kernel_launch: built for 256 CUs (one 256x256 unit per workgroup in the N = 2048 GEMMs), the device has %d; nothing launched\n", cus); grid = -1; return; }
        grid = cus;
    }
    if (grid < 0) return;
    if (hipMemsetAsync((char*)d_ws, 0, CTL_ZERO_BYTES, stream) != hipSuccess) { fprintf(stderr, "kernel_launch: hipMemsetAsync failed\n"); return; }
    Args a{};
    for (int i = 0; i < N_IN; ++i) a.in[i] = (const float*)d_in[i];
    a.out = (float*)d_out; a.ws = (unsigned char*)d_ws;
#if MK_PER_PHASE
    for (int p = 0; p < N_PHASES; ++p) { a.ph_lo = p; a.ph_hi = p + 1; hipLaunchKernelGGL(hybrid_fwd, dim3(grid), dim3(NWAVES * 64), LDS_BYTES, stream, a); }
#else
    a.ph_lo = 0; a.ph_hi = N_PHASES;
    hipLaunchKernelGGL(hybrid_fwd, dim3(grid), dim3(NWAVES * 64), LDS_BYTES, stream, a);
#endif
    const hipError_t le = hipPeekAtLastError();
    if (le != hipSuccess) fprintf(stderr, "kernel_launch: launch failed: %s\n", hipGetErrorName(le));
}
```
